# Optimizing an MI355X kernel written in HIP

```python
import math
import jax, jax.numpy as jnp
from jax import lax
import numpy as np

D_MODEL = 1024
BATCH = 8
SEQ = 8192
DEPTH = 2

CHUNK = 64
Q_BLOCK = 128
EPS = 1e-6

MLA_HEADS = 8
QK_NOPE_DIM = 64
QK_ROPE_DIM = 32
V_HEAD_DIM = 64
Q_LORA_RANK = 768
KV_LORA_RANK = 256
ROPE_THETA = 10000.0
MLA_WIDTH = MLA_HEADS * V_HEAD_DIM

SSD_HEADS = 8
SSD_HEAD_DIM = 64
SSD_INNER = SSD_HEADS * SSD_HEAD_DIM
SSD_GROUPS = 2
SSD_STATE = 128
CONV_WIDTH = 4
CONV_DIM = SSD_INNER + 2 * SSD_GROUPS * SSD_STATE

MIX_WIDTH = MLA_WIDTH + SSD_INNER
D_FF = 4 * D_MODEL
IN_PROJ_DIM = Q_LORA_RANK + KV_LORA_RANK + QK_ROPE_DIM + SSD_INNER + CONV_DIM + SSD_HEADS

kernel_name = "hymba_mla_ssd_sandwich_trunk"


def rms_norm(x, w):
    xf = x.astype(jnp.float32)
    xf = xf * lax.rsqrt(jnp.mean(xf * xf, axis=-1, keepdims=True) + EPS)
    return xf.astype(x.dtype) * w


def rope_tables(positions):
    inv_freq = ROPE_THETA ** (-jnp.arange(0, QK_ROPE_DIM, 2, dtype=jnp.float32) / QK_ROPE_DIM)
    ang = positions[..., None].astype(jnp.float32) * inv_freq
    return jnp.cos(ang), jnp.sin(ang)


def apply_rope(t, cos, sin):
    half = t.shape[-1] // 2
    t1 = t[..., :half].astype(jnp.float32)
    t2 = t[..., half:].astype(jnp.float32)
    return jnp.concatenate([t1 * cos - t2 * sin, t2 * cos + t1 * sin], axis=-1).astype(t.dtype)


def mla_mixer(c_q, c_kv, k_rope, cos, sin, q_norm_w, w_uq, kv_norm_w, w_ukv):
    B, S, _ = c_q.shape
    q = (rms_norm(c_q, q_norm_w) @ w_uq).reshape(B, S, MLA_HEADS, QK_NOPE_DIM + QK_ROPE_DIM)
    q_nope = q[..., :QK_NOPE_DIM]
    q_rope = apply_rope(q[..., QK_NOPE_DIM:], cos[:, :, None], sin[:, :, None])
    k_rope = apply_rope(k_rope, cos, sin)
    kv = (rms_norm(c_kv, kv_norm_w) @ w_ukv).reshape(B, S, MLA_HEADS, QK_NOPE_DIM + V_HEAD_DIM)
    k_nope = kv[..., :QK_NOPE_DIM]
    v = kv[..., QK_NOPE_DIM:]
    scale = (QK_NOPE_DIM + QK_ROPE_DIM) ** -0.5
    nb = S // Q_BLOCK
    key_chunk = jnp.arange(S) // CHUNK

    def to_blocks(t):
        return jnp.moveaxis(t.reshape(B, nb, Q_BLOCK, *t.shape[2:]), 1, 0)

    def attend(args):
        blk, qn, qr = args
        s = (jnp.einsum("bqhd,bkhd->bhqk", qn, k_nope, preferred_element_type=jnp.float32)
             + jnp.einsum("bqhr,bkr->bhqk", qr, k_rope, preferred_element_type=jnp.float32)) * scale
        q_chunk = (blk * Q_BLOCK + jnp.arange(Q_BLOCK)) // CHUNK
        allowed = key_chunk[None, :] <= q_chunk[:, None]
        s = jnp.where(allowed[None, None], s, -jnp.inf)
        p = jax.nn.softmax(s, axis=-1).astype(v.dtype)
        return jnp.einsum("bhqk,bkhd->bqhd", p, v)

    o = lax.map(attend, (jnp.arange(nb), to_blocks(q_nope), to_blocks(q_rope)))
    return jnp.moveaxis(o, 0, 1).reshape(B, S, MLA_WIDTH)


def causal_depthwise_conv(x, w, b):
    S = x.shape[1]
    xp = jnp.pad(x, ((0, 0), (CONV_WIDTH - 1, 0), (0, 0)))
    y = xp[:, 0:S] * w[0]
    for k in range(1, CONV_WIDTH):
        y = y + xp[:, k:k + S] * w[k]
    return y + b


def segsum(a):
    L = a.shape[-1]
    cs = jnp.cumsum(a, axis=-1)
    diff = cs[..., :, None] - cs[..., None, :]
    tril = jnp.tril(jnp.ones((L, L), dtype=bool))
    return jnp.where(tril, diff, -jnp.inf)


def ssd_chunked(x, dt, A, Bm, Cm):
    Bsz, S, H, P = x.shape
    nc = S // CHUNK
    rep = H // SSD_GROUPS
    xdt = (x * dt[..., None]).reshape(Bsz, nc, CHUNK, H, P)
    a = jnp.transpose((dt * A).reshape(Bsz, nc, CHUNK, H), (0, 3, 1, 2))
    Bh = jnp.repeat(Bm, rep, axis=2).reshape(Bsz, nc, CHUNK, H, SSD_STATE)
    Ch = jnp.repeat(Cm, rep, axis=2).reshape(Bsz, nc, CHUNK, H, SSD_STATE)
    a_cs = jnp.cumsum(a, axis=-1)
    decay_in = jnp.exp(segsum(a))
    scores = jnp.einsum("bclhn,bcshn->bhcls", Ch, Bh) * decay_in
    y_diag = jnp.einsum("bhcls,bcshp->bclhp", scores, xdt)
    decay_states = jnp.exp(a_cs[..., -1:] - a_cs)
    states = jnp.einsum("bcshn,bhcs,bcshp->bchpn", Bh, decay_states, xdt)
    chunk_decay = jnp.exp(a_cs[..., -1])

    def step(h, inp):
        st, dec = inp
        return h * dec[..., None, None] + st, h

    init = jnp.zeros((Bsz, H, P, SSD_STATE), dtype=x.dtype)
    _, prev = lax.scan(step, init, (jnp.moveaxis(states, 1, 0), jnp.moveaxis(chunk_decay, 2, 0)))
    prev = jnp.moveaxis(prev, 0, 1)
    y_off = jnp.einsum("bclhn,bchpn,bhcl->bclhp", Ch, prev, jnp.exp(a_cs))
    return (y_diag + y_off).reshape(Bsz, S, H, P)


def ssd_mixer(z, xbc, dt_raw, conv_w, conv_b, dt_bias, a_log, d_skip, ssd_norm_w):
    B, S, _ = z.shape
    out_dtype = z.dtype
    xbc = jax.nn.silu(causal_depthwise_conv(xbc, conv_w, conv_b)).astype(jnp.float32)
    xs = xbc[..., :SSD_INNER].reshape(B, S, SSD_HEADS, SSD_HEAD_DIM)
    Bm = xbc[..., SSD_INNER:SSD_INNER + SSD_GROUPS * SSD_STATE].reshape(B, S, SSD_GROUPS, SSD_STATE)
    Cm = xbc[..., SSD_INNER + SSD_GROUPS * SSD_STATE:].reshape(B, S, SSD_GROUPS, SSD_STATE)
    dt = jax.nn.softplus(dt_raw.astype(jnp.float32) + dt_bias.astype(jnp.float32))
    A = -jnp.exp(a_log.astype(jnp.float32))
    y = ssd_chunked(xs, dt, A, Bm, Cm) + d_skip.astype(jnp.float32)[:, None] * xs
    y = y.reshape(B, S, SSD_INNER) * jax.nn.silu(z.astype(jnp.float32))
    yg = y.reshape(B, S, SSD_GROUPS, SSD_INNER // SSD_GROUPS)
    yg = yg * lax.rsqrt(jnp.mean(yg * yg, axis=-1, keepdims=True) + EPS)
    return (yg.reshape(B, S, SSD_INNER) * ssd_norm_w.astype(jnp.float32)).astype(out_dtype)


def setup_inputs(seed: int = 0) -> dict:
    key = jax.random.key(seed)
    ks = jax.random.split(key, 24)
    f32 = jnp.float32

    def normal(k, shape, scale):
        return jax.random.normal(k, shape, f32) * scale

    def gain(k, shape):
        return 1.0 + 0.02 * jax.random.normal(k, shape, f32)

    x = jax.random.normal(ks[0], (BATCH, SEQ, D_MODEL), f32)
    offset = jax.random.randint(ks[1], (BATCH, 1), 0, 4096, dtype=jnp.int32)
    positions = (offset + jnp.arange(SEQ, dtype=jnp.int32)[None, :]).astype(jnp.int32)
    dt0 = jnp.exp(jax.random.uniform(ks[2], (DEPTH, SSD_HEADS), f32)
                  * (math.log(0.1) - math.log(0.001)) + math.log(0.001))
    dt_bias = dt0 + jnp.log(-jnp.expm1(-dt0))
    a_log = jnp.log(jax.random.uniform(ks[3], (DEPTH, SSD_HEADS), f32, minval=1.0, maxval=16.0))
    return {
        "x": x,
        "positions": positions,
        "pre_mix_norm": gain(ks[4], (DEPTH, D_MODEL)),
        "w_in": normal(ks[5], (DEPTH, D_MODEL, IN_PROJ_DIM), D_MODEL ** -0.5),
        "q_norm": gain(ks[6], (DEPTH, Q_LORA_RANK)),
        "w_uq": normal(ks[7], (DEPTH, Q_LORA_RANK, MLA_HEADS * (QK_NOPE_DIM + QK_ROPE_DIM)), Q_LORA_RANK ** -0.5),
        "kv_norm": gain(ks[8], (DEPTH, KV_LORA_RANK)),
        "w_ukv": normal(ks[9], (DEPTH, KV_LORA_RANK, MLA_HEADS * (QK_NOPE_DIM + V_HEAD_DIM)), KV_LORA_RANK ** -0.5),
        "conv_w": normal(ks[10], (DEPTH, CONV_WIDTH, CONV_DIM), CONV_WIDTH ** -0.5),
        "conv_b": normal(ks[11], (DEPTH, CONV_DIM), 0.01),
        "dt_bias": dt_bias,
        "a_log": a_log,
        "d_skip": gain(ks[12], (DEPTH, SSD_HEADS)),
        "ssd_norm": gain(ks[13], (DEPTH, SSD_INNER)),
        "w_out": normal(ks[14], (DEPTH, MIX_WIDTH, D_MODEL), MIX_WIDTH ** -0.5),
        "post_mix_norm": gain(ks[15], (DEPTH, D_MODEL)),
        "pre_mlp_norm": gain(ks[16], (DEPTH, D_MODEL)),
        "w_up": normal(ks[17], (DEPTH, D_MODEL, D_FF), D_MODEL ** -0.5),
        "w_down": normal(ks[18], (DEPTH, D_FF, D_MODEL), D_FF ** -0.5),
        "post_mlp_norm": gain(ks[19], (DEPTH, D_MODEL)),
    }


def reference(x, positions, pre_mix_norm, w_in, q_norm, w_uq, kv_norm, w_ukv, conv_w, conv_b,
              dt_bias, a_log, d_skip, ssd_norm, w_out, post_mix_norm, pre_mlp_norm, w_up,
              w_down, post_mlp_norm):
    cos, sin = rope_tables(positions)
    s1 = Q_LORA_RANK
    s2 = s1 + KV_LORA_RANK
    s3 = s2 + QK_ROPE_DIM
    s4 = s3 + SSD_INNER
    s5 = s4 + CONV_DIM
    h = x
    for l in range(DEPTH):
        u = rms_norm(h, pre_mix_norm[l])
        proj = u @ w_in[l]
        c_q, c_kv, k_rope = proj[..., :s1], proj[..., s1:s2], proj[..., s2:s3]
        z, xbc, dt_raw = proj[..., s3:s4], proj[..., s4:s5], proj[..., s5:]
        y_att = mla_mixer(c_q, c_kv, k_rope, cos, sin, q_norm[l], w_uq[l], kv_norm[l], w_ukv[l])
        y_ssd = ssd_mixer(z, xbc, dt_raw, conv_w[l], conv_b[l], dt_bias[l], a_log[l], d_skip[l], ssd_norm[l])
        mixed = jnp.concatenate([y_att, y_ssd], axis=-1) @ w_out[l]
        h = h + rms_norm(mixed, post_mix_norm[l])
        m = rms_norm(h, pre_mlp_norm[l])
        m = jnp.square(jax.nn.relu(m @ w_up[l])) @ w_down[l]
        h = h + rms_norm(m, post_mlp_norm[l])
    return h
```

```cpp
#include <hip/hip_runtime.h>
#include <hip/hip_cooperative_groups.h>
#include <cstdio>
#include <cstdint>
namespace cg = cooperative_groups;

#ifndef MK_COOP
#define MK_COOP 1
#endif

#ifndef PH_MASK
#define PH_MASK 0x1fff
#endif
#define LAS __attribute__((address_space(3)))
typedef unsigned short bf16_t;
typedef short bf16x8 __attribute__((ext_vector_type(8)));
typedef short s16x4 __attribute__((ext_vector_type(4)));
typedef float f32x4 __attribute__((ext_vector_type(4)));
typedef float f32x16 __attribute__((ext_vector_type(16)));
typedef unsigned u32x4 __attribute__((ext_vector_type(4)));
typedef unsigned u32x2 __attribute__((ext_vector_type(2)));
typedef float f32x2_t __attribute__((ext_vector_type(2)));
typedef __bf16 bf16x2_t __attribute__((ext_vector_type(2)));

constexpr int BATCH = 8, SEQ = 8192, DM = 1024, T = BATCH * SEQ;
constexpr int NQL = 768, NKVL = 256, NPROJ_SRC = 2600, NPROJ = 2816, DFF = 4096;
constexpr int NLAYER = 2;
constexpr float EPS = 1e-6f;
constexpr float QSCALE = 0.14724445f;
constexpr int NCHUNK = SEQ / 64;

constexpr size_t MiB = 1u << 20;
constexpr size_t W_LSTRIDE = 26 * MiB;
constexpr size_t W_IN = 0, W_UQ = W_IN + (size_t)NPROJ * 1024 * 2, W_UKV = W_UQ + 768 * 768 * 2, W_OUT = W_UKV + 1024 * 256 * 2,
                 W_UP = W_OUT + 1024 * 1024 * 2, W_DN = W_UP + (size_t)4096 * 1024 * 2, W_END = W_DN + (size_t)4096 * 1024 * 2;
static_assert(W_END <= W_LSTRIDE, "weights");
constexpr size_t WS_COS = 56 * MiB, WS_SIN = 60 * MiB, WS_SSQH = 64 * MiB, WS_SSQQ = 65 * MiB, WS_SSQKV = 68 * MiB, WS_SSQO = 69 * MiB,
                 WS_DT = 73 * MiB, WS_KR = 75 * MiB, WS_CDEC = 79 * MiB;
constexpr size_t WS_HB = 96 * MiB;
constexpr size_t WS_STATES = 896 * MiB;
constexpr size_t WS_CQ = 224 * MiB, WS_CKV = 320 * MiB, WS_Z = 352 * MiB, WS_XBC = 416 * MiB, WS_Q = 544 * MiB, WS_KN = 640 * MiB, WS_VT = 704 * MiB;
constexpr size_t WS_HID = 224 * MiB;
constexpr size_t WS_MIX = 224 * MiB;
constexpr size_t WS_Y = 768 * MiB;
constexpr size_t WS_NEED = 1024 * MiB;

constexpr size_t WS_BAR = 80 * MiB;
constexpr int LDS_MISC = 131072 + 1024;
constexpr int LDS_BYTES = 147456;

__device__ __forceinline__ int tid_opaque() { int t = threadIdx.x; asm volatile("" : "+v"(t)); return t; }
__device__ __forceinline__ unsigned pk2(float lo, float hi) { f32x2_t v = {lo, hi}; bf16x2_t b = __builtin_convertvector(v, bf16x2_t); return __builtin_bit_cast(unsigned, b); }
__device__ __forceinline__ float bf2f(unsigned short b) { return __uint_as_float(((unsigned)b) << 16); }
__device__ __forceinline__ float bflo(unsigned w) { return __uint_as_float(w << 16); }
__device__ __forceinline__ float bfhi(unsigned w) { return __uint_as_float(w & 0xffff0000u); }
__device__ __forceinline__ float siluf(float v) { return v * __builtin_amdgcn_rcpf(1.f + __expf(-v)); }

struct WsPtrs {
    unsigned char* ws;
#define WSP_B(name, off) __device__ __forceinline__ bf16_t* name() const { return (bf16_t*)(ws + (off)); }
#define WSP_F(name, off) __device__ __forceinline__ float* name() const { return (float*)(ws + (off)); }
    WSP_B(CQ, WS_CQ) WSP_B(CKV, WS_CKV) WSP_B(Z, WS_Z) WSP_B(XBC, WS_XBC) WSP_B(KR, WS_KR) WSP_B(Q, WS_Q) WSP_B(KN, WS_KN) WSP_B(VT, WS_VT)
    WSP_B(Y, WS_Y) WSP_B(MIX, WS_MIX) WSP_B(HID, WS_HID) WSP_B(HB, WS_HB) WSP_B(STATES, WS_STATES)
    WSP_F(DT, WS_DT) WSP_F(SSQH, WS_SSQH) WSP_F(SSQQ, WS_SSQQ) WSP_F(SSQKV, WS_SSQKV) WSP_F(SSQO, WS_SSQO) WSP_F(COS, WS_COS) WSP_F(SIN, WS_SIN) WSP_F(CDEC, WS_CDEC)
};

namespace pg8 {
constexpr int BM = 256, BK = 64, HALF = 128, HTB = HALF * BK * 2, STAGE_BYTES = 8 * HTB, NXCD = 8, WGM = 8;
__host__ __device__ __forceinline__ int lds_byte(int r, int c) { const int st = (r >> 4) * 2 + (c >> 5), rr = r & 15, cc = c & 31, ob = rr * 64 + cc * 2; return st * 1024 + (ob ^ (((ob >> 9) & 1) << 5)); }
__host__ __device__ __forceinline__ void stage_rc(int b, int& R, int& C) { const int st = b / 1024, sb = b % 1024, swz = sb ^ (((sb >> 9) & 1) << 5); R = (st >> 1) * 16 + swz / 64; C = (st & 1) * 32 + (swz % 64) / 2; }
__host__ __device__ __forceinline__ int perm32(int rho) { const int n = rho >> 4, i = rho & 15; return 8 * (i >> 2) + 4 * n + (i & 3); }
struct Unit { int pm, pn; };
struct Gemm { const bf16_t* A; const bf16_t* Bt; int M, N, K; };
struct StaticOrder {
    int nM, nN, nwg, G, c;
    __host__ __device__ void init(int M, int N, int G_, int c_) { nM = M / BM; nN = N / BM; nwg = nM * nN; G = G_; c = c_; }
    __host__ __device__ bool next(int i, Unit& u) const {
        const long L = (long)i * G + c; if (L >= nwg) return false;
        int wgid = (int)L; { const int q = nwg / NXCD, r = nwg % NXCD, xcd = wgid % NXCD, off = wgid / NXCD; wgid = (xcd < r ? xcd * (q + 1) : r * (q + 1) + (xcd - r) * q) + off; }
        const int nig = WGM * nN, gid = wgid / nig, fm = gid * WGM, gsz = (nM - fm) < WGM ? (nM - fm) : WGM;
        u.pm = fm + ((wgid % nig) % gsz); u.pn = (wgid % nig) / gsz; return true;
    }
    __device__ __forceinline__ void a_ready(const Unit&) const {}
    __device__ __forceinline__ void done(const Unit&) const {}
};

template <class Epi, class Sched, bool ALIGN_EPI = false, bool SP2 = false>
__device__ __forceinline__ void gemm_phase(LAS unsigned char* lds, const Gemm g, const Sched& S, const Epi& E) {
    const int tid = tid_opaque(), wid = __builtin_amdgcn_readfirstlane(tid >> 6), lane = tid & 63, wr = wid >> 2, wc = wid & 3, fr = lane & 15, fq = lane >> 4;
    const int K = g.K, nt = K / BK;
    unsigned voffA[2], voffB[2];
#pragma unroll
    for (int i = 0; i < 2; ++i) { int R, C; stage_rc(tid * 16 + i * 8192, R, C); const int Rb = Epi::PERM ? ((R & ~31) + perm32(R & 31)) : R;
        voffA[i] = (unsigned)(R * K + C) * 2u; voffB[i] = (unsigned)(Rb * K + C) * 2u; }
    const size_t kstep = (size_t)(BK * 2);
    const size_t hstep = (size_t)HALF * K * 2;
    const size_t tstep = 2 * hstep;
    const unsigned ldsw = (unsigned)wid * 1024u;
    const int aoff = lds_byte(wr * 64 + fr, fq * 8), boff = lds_byte(wc * 32 + fr, fq * 8);
#define PG8_SA(b, h) (((b) * 2 + (h)) * HTB)
#define PG8_SB(b, h) ((4 + (b) * 2 + (h)) * HTB)
#define PG8_STAGE(bufoff, gbase, voff) do { _Pragma("unroll") for (int _i = 0; _i < 2; ++_i) \
        __builtin_amdgcn_global_load_lds((const unsigned*)((const char*)(gbase) + (voff)[_i]), (LAS unsigned*)(lds + (bufoff) + ldsw + _i * 8192), 16, 0, 0); } while (0)
#define PG8_LDA(dst, b, h) do { _Pragma("unroll") for (int m = 0; m < 4; ++m) _Pragma("unroll") for (int k = 0; k < 2; ++k) dst[m][k] = *(const LAS bf16x8*)(lds + PG8_SA(b, h) + aoff + m * 2048 + k * 1024); } while (0)
#define PG8_LDB(dst, b, h) do { _Pragma("unroll") for (int n = 0; n < 2; ++n) _Pragma("unroll") for (int k = 0; k < 2; ++k) dst[n][k] = *(const LAS bf16x8*)(lds + PG8_SB(b, h) + boff + n * 2048 + k * 1024); } while (0)
#define PG8_MMA(ai, bj, At, Bt) do { __builtin_amdgcn_s_setprio(1); _Pragma("unroll") for (int m = 0; m < 4; ++m) _Pragma("unroll") for (int n = 0; n < 2; ++n) _Pragma("unroll") for (int k = 0; k < 2; ++k) \
        acc[ai][bj][m][n] = __builtin_amdgcn_mfma_f32_16x16x32_bf16(Bt[n][k], At[m][k], acc[ai][bj][m][n], 0, 0, 0); __builtin_amdgcn_s_setprio(0); } while (0)
#define PG8_WAIT_V(n) asm volatile("s_waitcnt vmcnt(" #n ")" ::: "memory")
#define PG8_WAIT_L(n) asm volatile("s_waitcnt lgkmcnt(" #n ")" ::: "memory")
#define PG8_BAR __builtin_amdgcn_s_barrier()
#define PG8_SCHED __builtin_amdgcn_sched_barrier(0)
    Unit cur, nxt; int ui = 0;
    if (!S.next(0, cur)) return;
    f32x4 acc[2][2][4][2];
#pragma unroll
    for (int a = 0; a < 2; ++a)
#pragma unroll
        for (int b = 0; b < 2; ++b)
#pragma unroll
            for (int m = 0; m < 4; ++m)
#pragma unroll
                for (int n = 0; n < 2; ++n) acc[a][b][m][n] = (f32x4){0.f, 0.f, 0.f, 0.f};
    bf16x8 At[4][2], B0[2][2], B1[2][2];
    const char* cA = (const char*)g.A + (size_t)cur.pm * tstep; const char* cB = (const char*)g.Bt + (size_t)cur.pn * tstep;
    S.a_ready(cur);
    if constexpr (SP2) {
        PG8_STAGE(PG8_SB(0, 0), cB, voffB); PG8_STAGE(PG8_SB(0, 1), cB + hstep, voffB); PG8_STAGE(PG8_SA(0, 0), cA, voffA); PG8_STAGE(PG8_SA(0, 1), cA + hstep, voffA);
        if (wr == 1) PG8_BAR;
        PG8_WAIT_V(2); PG8_BAR;
        PG8_STAGE(PG8_SB(1, 0), cB + kstep, voffB); PG8_STAGE(PG8_SA(1, 0), cA + kstep, voffA); PG8_STAGE(PG8_SB(1, 1), cB + hstep + kstep, voffB);
        PG8_WAIT_V(6); PG8_BAR;
    } else {
        PG8_STAGE(PG8_SB(0, 0), cB, voffB); PG8_STAGE(PG8_SA(0, 0), cA, voffA); PG8_STAGE(PG8_SB(0, 1), cB + hstep, voffB); PG8_STAGE(PG8_SA(0, 1), cA + hstep, voffA);
        if (wr == 1) PG8_BAR;
        PG8_WAIT_V(4); PG8_BAR;
        PG8_STAGE(PG8_SB(1, 0), cB + kstep, voffB); PG8_STAGE(PG8_SA(1, 0), cA + kstep, voffA); PG8_STAGE(PG8_SB(1, 1), cB + hstep + kstep, voffB);
        PG8_WAIT_V(6); PG8_BAR;
    }
    for (;;) {
        const bool has_next = S.next(ui + 1, nxt);
        const char* nA = has_next ? (const char*)g.A + (size_t)nxt.pm * tstep : cA; const char* nB = has_next ? (const char*)g.Bt + (size_t)nxt.pn * tstep : cB;
        for (int t = 0; t < nt; t += 2) {
            const bool last = (t == nt - 2);
            const char* a1 = cA + (size_t)(t + 1) * kstep;
            const char* a2 = last ? nA : cA + (size_t)(t + 2) * kstep; const char* b2 = last ? nB : cB + (size_t)(t + 2) * kstep;
            const char* a3 = a2 + kstep; const char* b3 = b2 + kstep;
            if (last && has_next) S.a_ready(nxt);
            if constexpr (SP2) {
            PG8_LDB(B0, 0, 0); PG8_LDB(B1, 0, 1); PG8_SCHED; PG8_LDA(At, 0, 0); PG8_STAGE(PG8_SA(1, 1), a1 + hstep, voffA);
            PG8_WAIT_V(8); PG8_WAIT_L(0); PG8_BAR; PG8_MMA(0, 0, At, B0); PG8_MMA(0, 1, At, B1); PG8_BAR; PG8_SCHED;
            PG8_LDA(At, 0, 1); PG8_STAGE(PG8_SB(0, 0), b2, voffB); PG8_STAGE(PG8_SB(0, 1), b2 + hstep, voffB); PG8_STAGE(PG8_SA(0, 0), a2, voffA);
            PG8_WAIT_V(8); PG8_WAIT_L(0); PG8_BAR; PG8_MMA(1, 0, At, B0); PG8_MMA(1, 1, At, B1); PG8_BAR; PG8_SCHED;
            PG8_LDB(B0, 1, 0); PG8_LDB(B1, 1, 1); PG8_SCHED; PG8_LDA(At, 1, 0); PG8_STAGE(PG8_SA(0, 1), a2 + hstep, voffA);
            PG8_WAIT_V(8); PG8_WAIT_L(0); PG8_BAR; PG8_MMA(0, 0, At, B0); PG8_MMA(0, 1, At, B1); PG8_BAR; PG8_SCHED;
            PG8_LDA(At, 1, 1); PG8_STAGE(PG8_SB(1, 0), b3, voffB); PG8_STAGE(PG8_SB(1, 1), b3 + hstep, voffB); PG8_STAGE(PG8_SA(1, 0), a3, voffA);
            PG8_WAIT_V(8); PG8_WAIT_L(0); PG8_BAR; PG8_MMA(1, 0, At, B0); PG8_MMA(1, 1, At, B1); PG8_BAR; PG8_SCHED;
            } else {
            PG8_LDB(B0, 0, 0); PG8_SCHED; PG8_LDA(At, 0, 0); PG8_STAGE(PG8_SA(1, 1), a1 + hstep, voffA);
            PG8_WAIT_L(8); PG8_BAR; PG8_WAIT_L(0); PG8_MMA(0, 0, At, B0); PG8_BAR; PG8_SCHED;
            PG8_LDB(B1, 0, 1); PG8_STAGE(PG8_SB(0, 0), b2, voffB);
            PG8_BAR; PG8_WAIT_L(0); PG8_MMA(0, 1, At, B1); PG8_BAR;
            PG8_LDA(At, 0, 1); PG8_STAGE(PG8_SA(0, 0), a2, voffA);
            PG8_BAR; PG8_WAIT_L(0); PG8_MMA(1, 0, At, B0); PG8_BAR; PG8_SCHED;
            PG8_STAGE(PG8_SB(0, 1), b2 + hstep, voffB);
            PG8_WAIT_V(6); PG8_BAR; PG8_MMA(1, 1, At, B1); PG8_BAR;
            PG8_LDB(B0, 1, 0); PG8_SCHED; PG8_LDA(At, 1, 0); PG8_STAGE(PG8_SA(0, 1), a2 + hstep, voffA);
            PG8_WAIT_L(8); PG8_BAR; PG8_WAIT_L(0); PG8_MMA(0, 0, At, B0); PG8_BAR; PG8_SCHED;
            PG8_LDB(B1, 1, 1); PG8_STAGE(PG8_SB(1, 0), b3, voffB);
            PG8_BAR; PG8_WAIT_L(0); PG8_MMA(0, 1, At, B1); PG8_BAR;
            PG8_LDA(At, 1, 1); PG8_STAGE(PG8_SA(1, 0), a3, voffA);
            PG8_BAR; PG8_WAIT_L(0); PG8_MMA(1, 0, At, B0); PG8_BAR; PG8_SCHED;
            PG8_STAGE(PG8_SB(1, 1), b3 + hstep, voffB);
            PG8_WAIT_V(6); PG8_BAR; PG8_MMA(1, 1, At, B1); PG8_BAR;
            }
        }
        if constexpr (ALIGN_EPI) { if (wr == 0) PG8_BAR; }
        E(acc, cur, wr, wc, fr, fq); S.done(cur);
        if (!has_next) break;
#pragma unroll
        for (int a = 0; a < 2; ++a)
#pragma unroll
            for (int b = 0; b < 2; ++b)
#pragma unroll
                for (int m = 0; m < 4; ++m)
#pragma unroll
                    for (int n = 0; n < 2; ++n) acc[a][b][m][n] = (f32x4){0.f, 0.f, 0.f, 0.f};
        cur = nxt; cA = nA; cB = nB; ++ui;
        if constexpr (ALIGN_EPI) { if (wr == 1) PG8_BAR; }
    }
    PG8_WAIT_V(0);
    if constexpr (!ALIGN_EPI) { if (wr == 0) PG8_BAR; }
    PG8_BAR;
#undef PG8_SA
#undef PG8_SB
#undef PG8_STAGE
#undef PG8_LDA
#undef PG8_LDB
#undef PG8_MMA
#undef PG8_WAIT_V
#undef PG8_WAIT_L
#undef PG8_BAR
#undef PG8_SCHED
}
}

enum { M_INPROJ = 0, M_Q = 1, M_KV = 2, M_OUT = 3, M_UP = 4 };
__device__ __forceinline__ void st_bf4(bf16_t* p, f32x4 v) { u32x2 w; w.x = pk2(v[0], v[1]); w.y = pk2(v[2], v[3]); *(u32x2*)p = w; }
__device__ __forceinline__ float dot4(f32x4 v) { return (v[0] * v[0] + v[1] * v[1]) + (v[2] * v[2] + v[3] * v[3]); }
__device__ __forceinline__ float softplusf(float x) { return x > 20.f ? x : log1pf(__expf(x)); }

__device__ __forceinline__ void st_bf8(bf16_t* p, f32x4 a, f32x4 b) { u32x4 w; w.x = pk2(a[0], a[1]); w.y = pk2(a[2], a[3]); w.z = pk2(b[0], b[1]); w.w = pk2(b[2], b[3]); *(u32x4*)p = w; }
__device__ __forceinline__ f32x4 shfl32_4(f32x4 v) { f32x4 r; r[0] = __shfl_xor(v[0], 32); r[1] = __shfl_xor(v[1], 32); r[2] = __shfl_xor(v[2], 32); r[3] = __shfl_xor(v[3], 32); return r; }
__device__ __forceinline__ void rope_perm(f32x4& v0, f32x4& v1, const float* COS, const float* SIN, int row, int fq) {
    const f32x4 p0 = shfl32_4(v0), p1 = shfl32_4(v1);
    const int i0 = 8 * (fq & 1);
    const f32x4 c0 = *(const f32x4*)(COS + (size_t)row * 16 + i0), c1 = *(const f32x4*)(COS + (size_t)row * 16 + i0 + 4);
    const f32x4 s0 = *(const f32x4*)(SIN + (size_t)row * 16 + i0), s1 = *(const f32x4*)(SIN + (size_t)row * 16 + i0 + 4);
    if (fq < 2) { v0 = v0 * c0 - p0 * s0; v1 = v1 * c1 - p1 * s1; }
    else        { v0 = v0 * c0 + p0 * s0; v1 = v1 * c1 + p1 * s1; }
}

template <int MODE> struct Epi {
    static constexpr bool PERM = true, AFTER_DRAIN = false;
    WsPtrs P; const float* dtb; bf16_t* dst;
    __device__ __forceinline__ void operator()(const f32x4 (&acc)[2][2][4][2], const pg8::Unit& u, int wr, int wc, int fr, int fq) const {
        const int pn = u.pn;
        const int rowb = u.pm * 256 + wr * 64 + fr;
#pragma unroll
        for (int ai = 0; ai < 2; ++ai)
#pragma unroll
            for (int m = 0; m < 4; ++m) {
                const int row = rowb + ai * 128 + m * 16;
                if constexpr (MODE == M_INPROJ) {
                    const float rstd = rsqrtf(P.SSQH()[row] * (1.f / 1024.f) + EPS);
                    if (pn < 10) {
                        bf16_t* d; int ld, colt;
                        if (pn < 3) { d = P.CQ(); ld = 768; colt = pn * 256; } else if (pn == 3) { d = P.CKV(); ld = 256; colt = 0; }
                        else if (pn < 6) { d = P.Z(); ld = 512; colt = (pn - 4) * 256; } else { d = P.XBC(); ld = 1024; colt = (pn - 6) * 256; }
                        bf16_t* rp = d + (size_t)row * ld + colt + wc * 32 + 8 * fq;
                        float ss = 0.f;
#pragma unroll
                        for (int bj = 0; bj < 2; ++bj) { const f32x4 v0 = acc[ai][bj][m][0] * rstd, v1 = acc[ai][bj][m][1] * rstd; if (pn < 4) ss += dot4(v0) + dot4(v1); st_bf8(rp + bj * 128, v0, v1); }
                        if (pn < 4) { ss += __shfl_xor(ss, 16); ss += __shfl_xor(ss, 32);
                            if (fq == 0) { if (pn < 3) P.SSQQ()[(size_t)row * 12 + pn * 4 + wc] = ss; else P.SSQKV()[(size_t)row * 4 + wc] = ss; } }
                    } else {
                        if (wc == 0) {
                            f32x4 v0 = acc[ai][0][m][0] * rstd, v1 = acc[ai][0][m][1] * rstd;
                            rope_perm(v0, v1, P.COS(), P.SIN(), row, fq);
                            st_bf8(P.KR() + (size_t)row * 32 + 8 * fq, v0, v1);
                        } else if (wc == 1) {
                            if (fq == 0) { const f32x4 v0 = acc[ai][0][m][0] * rstd, v1 = acc[ai][0][m][1] * rstd; f32x4 o0, o1;
#pragma unroll
                                for (int j = 0; j < 4; ++j) { o0[j] = softplusf(v0[j] + dtb[j]); o1[j] = softplusf(v1[j] + dtb[4 + j]); }
                                *(f32x4*)(P.DT() + (size_t)row * 8) = o0; *(f32x4*)(P.DT() + (size_t)row * 8 + 4) = o1; }
                        }
                    }
                    asm volatile("" ::: "memory");
                } else if constexpr (MODE == M_Q) {
                    const f32x4 s0 = *(const f32x4*)(P.SSQQ() + (size_t)row * 12), s1 = *(const f32x4*)(P.SSQQ() + (size_t)row * 12 + 4), s2 = *(const f32x4*)(P.SSQQ() + (size_t)row * 12 + 8);
                    const float ssq = ((s0[0] + s0[1]) + (s0[2] + s0[3])) + ((s1[0] + s1[1]) + (s1[2] + s1[3])) + ((s2[0] + s2[1]) + (s2[2] + s2[3]));
                    const float rstd = rsqrtf(ssq * (1.f / 768.f) + EPS) * QSCALE;
#pragma unroll
                    for (int bj = 0; bj < 2; ++bj) {
                        const int gcol = pn * 256 + bj * 128 + wc * 32;
                        f32x4 v0 = acc[ai][bj][m][0] * rstd, v1 = acc[ai][bj][m][1] * rstd;
                        if ((gcol % 96) == 64) rope_perm(v0, v1, P.COS(), P.SIN(), row, fq);
                        st_bf8(P.Q() + (size_t)row * 768 + gcol + 8 * fq, v0, v1);
                    }
                } else if constexpr (MODE == M_KV) {
                    const f32x4 s0 = *(const f32x4*)(P.SSQKV() + (size_t)row * 4);
                    const float rstd = rsqrtf(((s0[0] + s0[1]) + (s0[2] + s0[3])) * (1.f / 256.f) + EPS);
                    if (wc < 2) {
                        char* kb_ = (char*)P.KN() + (size_t)(pn * 128) * 2;
                        const unsigned off = ((unsigned)row * 512u + (unsigned)(wc * 32 + 8 * fq)) * 2u;
#pragma unroll
                        for (int bj = 0; bj < 2; ++bj) st_bf8((bf16_t*)(kb_ + (off + (unsigned)(bj * 64) * 2u)), acc[ai][bj][m][0] * rstd, acc[ai][bj][m][1] * rstd);
                    } else {
                        const int b = (u.pm * 256) >> 13;
                        char* vb_ = (char*)P.VT() + ((size_t)((b * 8 + pn * 2) * 64 + (wc - 2) * 32)) * SEQ * 2;
                        const unsigned off = ((unsigned)(8 * fq) * (unsigned)SEQ + (unsigned)(row & (SEQ - 1))) * 2u;
#pragma unroll
                        for (int bj = 0; bj < 2; ++bj)
#pragma unroll
                            for (int n = 0; n < 2; ++n) { const f32x4 v = acc[ai][bj][m][n] * rstd;
#pragma unroll
                                for (int j = 0; j < 4; ++j)
                                    *(bf16_t*)(vb_ + (off + (unsigned)((bj * 64 + n * 4 + j) * SEQ) * 2u)) = (bf16_t)(pk2(v[j], 0.f) & 0xffffu); }
                    }
                    asm volatile("" ::: "memory");
                } else if constexpr (MODE == M_OUT) {
                    bf16_t* rp = dst + (size_t)row * 1024 + pn * 256 + wc * 32 + 8 * fq;
                    float ss = 0.f;
#pragma unroll
                    for (int bj = 0; bj < 2; ++bj) { const f32x4 v0 = acc[ai][bj][m][0], v1 = acc[ai][bj][m][1]; ss += dot4(v0) + dot4(v1); st_bf8(rp + bj * 128, v0, v1); }
                    ss += __shfl_xor(ss, 16); ss += __shfl_xor(ss, 32);
                    if (fq == 0) P.SSQO()[(size_t)row * 16 + pn * 4 + wc] = ss;
                } else {
                    const float rstd = rsqrtf(P.SSQH()[row] * (1.f / 1024.f) + EPS);
                    bf16_t* rp = P.HID() + (size_t)row * DFF + pn * 256 + wc * 32 + 8 * fq;
#pragma unroll
                    for (int bj = 0; bj < 2; ++bj) {
                        f32x4 v0 = acc[ai][bj][m][0] * rstd, v1 = acc[ai][bj][m][1] * rstd;
#pragma unroll
                        for (int j = 0; j < 4; ++j) { float r0, r1; asm("v_max_f32_e32 %0, 0, %1" : "=v"(r0) : "v"(v0[j])); asm("v_max_f32_e32 %0, 0, %1" : "=v"(r1) : "v"(v1[j])); v0[j] = r0; v1[j] = r1; }
                        v0 = v0 * v0; v1 = v1 * v1;
                        u32x4 w_; w_.x = pk2(v0[0], v0[1]); w_.y = pk2(v0[2], v0[3]); w_.z = pk2(v1[0], v1[1]); w_.w = pk2(v1[2], v1[3]);
                        __builtin_nontemporal_store(w_, (u32x4*)(rp + bj * 128));
                    }
                }
            }
    }
};

__device__ __forceinline__ float wave_sum(float v) {
#pragma unroll
    for (int o = 1; o < 64; o <<= 1) v += __shfl_xor(v, o);
    return v;
}
__device__ __forceinline__ void transpose_item(const float* W, int K, int N, bf16_t* WT, const float* nw, int mapmode, LAS float* scr, int item, int lane) {
    const int nblk = (N + 31) / 32, kb = item / nblk, nb = item % nblk, k0 = 64 * kb, n0 = 32 * nb;
#pragma unroll
    for (int i = 0; i < 8; ++i) { const int kk = 8 * i + (lane >> 3); const int n = n0 + 4 * (lane & 7);
        f32x4 v = (n < N) ? *(const f32x4*)(W + (size_t)(k0 + kk) * N + n) : (f32x4){0.f, 0.f, 0.f, 0.f}; if (nw) v = v * nw[k0 + kk];
        LAS float* d = scr + kk * 33 + 4 * (lane & 7); d[0] = v[0]; d[1] = v[1]; d[2] = v[2]; d[3] = v[3]; }
    asm volatile("s_waitcnt lgkmcnt(0)" ::: "memory");
    const int c = lane & 7;
#pragma unroll
    for (int j = 0; j < 4; ++j) { const int nl = (lane >> 3) + 8 * j; const int n = n0 + nl; const LAS float* s = scr + (8 * c) * 33 + nl;
        if (n < N) {
            int row = n;
            if (mapmode) { if (n >= 1024 && n < 1056) row = 2560 + (n - 1024); else if (n >= 1056 && n < 2592) row = n - 32; }
            u32x4 o; o.x = pk2(s[0 * 33], s[1 * 33]); o.y = pk2(s[2 * 33], s[3 * 33]); o.z = pk2(s[4 * 33], s[5 * 33]); o.w = pk2(s[6 * 33], s[7 * 33]);
            *(u32x4*)(WT + (size_t)row * K + k0 + 8 * c) = o; } }
    asm volatile("s_waitcnt lgkmcnt(0)" ::: "memory");
}

__constant__ float c_invf[16] = {1.0f, 0.5623413324356079f, 0.3162277638912201f, 0.17782793939113617f, 0.10000000149011612f, 0.05623413249850273f, 0.03162277489900589f, 0.017782794311642647f,
    0.009999999776482582f, 0.005623413249850273f, 0.003162277629598975f, 0.0017782794311642647f, 0.0010000000474974513f, 0.000562341301701963f, 0.0003162277571391314f, 0.00017782794020604342f};

struct Params { const float* in[20]; float* out; unsigned char* ws; int ph_lo, ph_hi; };
typedef const __attribute__((address_space(4))) Params* KP;
__device__ __forceinline__ KP kargs() { KP q = (KP)__builtin_amdgcn_kernarg_segment_ptr(); asm volatile("" : "+s"(q)); return q; }

__device__ __forceinline__ void phase_prep(KP pk, const WsPtrs& P, LAS unsigned char* lds, int vcu, int G) {
    const int tid = tid_opaque(), lane = tid & 63, wave = __builtin_amdgcn_readfirstlane(tid >> 6);
    LAS float* scr = (LAS float*)(lds + wave * 8448);
    const int gw = vcu * 8 + wave, NGW = G * 8;
    constexpr int I_IN = 16 * 82, I_UQ = 12 * 24, I_UKV = 4 * 32, I_OUT = 16 * 32, I_UP = 16 * 128, I_DN = 64 * 32, I_L = I_IN + I_UQ + I_UKV + I_OUT + I_UP + I_DN;
    for (int it = gw; it < NLAYER * I_L; it += NGW) {
        const int l = it / I_L; int r = it % I_L;
        unsigned char* wb = pk->ws + (size_t)l * W_LSTRIDE;
        if (r < I_IN) { transpose_item(pk->in[3] + (size_t)l * 1024 * NPROJ_SRC, 1024, NPROJ_SRC, (bf16_t*)(wb + W_IN), pk->in[2] + l * 1024, 1, scr, r, lane); continue; } r -= I_IN;
        if (r < I_UQ) { transpose_item(pk->in[5] + (size_t)l * 768 * 768, 768, 768, (bf16_t*)(wb + W_UQ), pk->in[4] + l * 768, 0, scr, r, lane); continue; } r -= I_UQ;
        if (r < I_UKV) { transpose_item(pk->in[7] + (size_t)l * 256 * 1024, 256, 1024, (bf16_t*)(wb + W_UKV), pk->in[6] + l * 256, 0, scr, r, lane); continue; } r -= I_UKV;
        if (r < I_OUT) { transpose_item(pk->in[14] + (size_t)l * 1024 * 1024, 1024, 1024, (bf16_t*)(wb + W_OUT), nullptr, 0, scr, r, lane); continue; } r -= I_OUT;
        if (r < I_UP) { transpose_item(pk->in[17] + (size_t)l * 1024 * 4096, 1024, 4096, (bf16_t*)(wb + W_UP), pk->in[16] + l * 1024, 0, scr, r, lane); continue; } r -= I_UP;
        transpose_item(pk->in[18] + (size_t)l * 4096 * 1024, 4096, 1024, (bf16_t*)(wb + W_DN), nullptr, 0, scr, r, lane);
    }
    { const int gt = vcu * 512 + tid, NT_ = G * 512; constexpr int NZ16 = 216 * 1024 * 2 / 16;
      for (int i = gt; i < NLAYER * NZ16; i += NT_) { const int l = i / NZ16, r = i % NZ16;
          *(u32x4*)(pk->ws + (size_t)l * W_LSTRIDE + W_IN + (size_t)2600 * 1024 * 2 + (size_t)r * 16) = (u32x4){0u, 0u, 0u, 0u}; } }
    { const int gt = vcu * 512 + tid, NT_ = G * 512; const int* pos = (const int*)pk->in[1];
      for (int i = gt; i < T * 16; i += NT_) { const int t = i >> 4, k = i & 15;
          const float ang = (float)pos[t] * c_invf[k];
          double rev = (double)ang * 0.15915494309189535; rev -= __builtin_rint(rev); const float fr = (float)rev;
          P.COS()[i] = __builtin_amdgcn_cosf(fr); P.SIN()[i] = __builtin_amdgcn_sinf(fr); } }
    for (int row = gw; row < T; row += NGW) {
        const f32x4* xr = (const f32x4*)(pk->in[0] + (size_t)row * DM) + lane; float ss = 0.f;
        u32x2* ob = (u32x2*)(P.HB() + (size_t)row * DM) + lane;
#pragma unroll
        for (int j = 0; j < 4; ++j) { const f32x4 v = __builtin_nontemporal_load(xr + 64 * j); ss += dot4(v); u32x2 w; w.x = pk2(v[0], v[1]); w.y = pk2(v[2], v[3]); ob[64 * j] = w; }
        ss = wave_sum(ss); if (lane == 0) P.SSQH()[row] = ss;
    }
}

template <bool IN_F32, bool OUT_F32>
__device__ __forceinline__ void phase_residual(const float* hin32, float* hout32, const bf16_t* mix, const float* nw, const WsPtrs& P, int vcu, int G) {
    const int tid = tid_opaque(), lane = tid & 63, wave = __builtin_amdgcn_readfirstlane(tid >> 6);
    const int gw = vcu * 8 + wave, NGW = G * 8;
    if constexpr (!IN_F32 && !OUT_F32) {
        f32x4 wa[2], wb[2];
#pragma unroll
        for (int j = 0; j < 2; ++j) { wa[j] = *(const f32x4*)(nw + 8 * lane + 512 * j); wb[j] = *(const f32x4*)(nw + 8 * lane + 512 * j + 4); }
        for (int row0 = gw; row0 < T; row0 += 2 * NGW) {
            float sq[2]; u32x4 hw[2][2], mw[2][2];
#pragma unroll
            for (int k = 0; k < 2; ++k) { const int row = row0 + k * NGW;
                sq[k] = P.SSQO()[(size_t)row * 16 + (lane & 15)];
#pragma unroll
                for (int j = 0; j < 2; ++j) { hw[k][j] = *((const u32x4*)(P.HB() + (size_t)row * DM) + lane + 64 * j); mw[k][j] = __builtin_nontemporal_load((const u32x4*)(mix + (size_t)row * DM) + lane + 64 * j); } }
#pragma unroll
            for (int k = 0; k < 2; ++k) { const int row = row0 + k * NGW;
                float s_ = sq[k]; s_ += __shfl_xor(s_, 1); s_ += __shfl_xor(s_, 2); s_ += __shfl_xor(s_, 4); s_ += __shfl_xor(s_, 8);
                const float rstd = rsqrtf(s_ * (1.f / 1024.f) + EPS);
                float ss = 0.f;
#pragma unroll
                for (int j = 0; j < 2; ++j) {
                    const f32x4 xa = {bflo(hw[k][j].x), bfhi(hw[k][j].x), bflo(hw[k][j].y), bfhi(hw[k][j].y)}, xb = {bflo(hw[k][j].z), bfhi(hw[k][j].z), bflo(hw[k][j].w), bfhi(hw[k][j].w)};
                    const f32x4 ma = {bflo(mw[k][j].x), bfhi(mw[k][j].x), bflo(mw[k][j].y), bfhi(mw[k][j].y)}, mb = {bflo(mw[k][j].z), bfhi(mw[k][j].z), bflo(mw[k][j].w), bfhi(mw[k][j].w)};
                    const f32x4 ha = xa + ma * rstd * wa[j], hb_ = xb + mb * rstd * wb[j];
                    ss += dot4(ha) + dot4(hb_);
                    u32x4 o; o.x = pk2(ha[0], ha[1]); o.y = pk2(ha[2], ha[3]); o.z = pk2(hb_[0], hb_[1]); o.w = pk2(hb_[2], hb_[3]);
                    *((u32x4*)(P.HB() + (size_t)row * DM) + lane + 64 * j) = o;
                }
                ss = wave_sum(ss); if (lane == 0) P.SSQH()[row] = ss; }
        }
        return;
    }
    f32x4 w4[4];
#pragma unroll
    for (int j = 0; j < 4; ++j) w4[j] = *((const f32x4*)nw + lane + 64 * j);
    for (int row0 = gw; row0 < T; row0 += 2 * NGW) {
        float sq[2]; u32x2 hw[2][4], mw[2][4]; f32x4 xf[2][4];
#pragma unroll
        for (int k = 0; k < 2; ++k) { const int row = row0 + k * NGW;
            sq[k] = P.SSQO()[(size_t)row * 16 + (lane & 15)];
#pragma unroll
            for (int j = 0; j < 4; ++j) {
                if (IN_F32) xf[k][j] = __builtin_nontemporal_load((const f32x4*)(hin32 + (size_t)row * DM) + lane + 64 * j);
                else hw[k][j] = ((const u32x2*)(P.HB() + (size_t)row * DM) + lane)[64 * j];
                mw[k][j] = __builtin_nontemporal_load((const u32x2*)(mix + (size_t)row * DM) + lane + 64 * j); } }
#pragma unroll
        for (int k = 0; k < 2; ++k) { const int row = row0 + k * NGW;
            float s_ = sq[k]; s_ += __shfl_xor(s_, 1); s_ += __shfl_xor(s_, 2); s_ += __shfl_xor(s_, 4); s_ += __shfl_xor(s_, 8);
            const float rstd = rsqrtf(s_ * (1.f / 1024.f) + EPS);
            u32x2* hb = (u32x2*)(P.HB() + (size_t)row * DM) + lane;
            float ss = 0.f;
#pragma unroll
            for (int j = 0; j < 4; ++j) {
                f32x4 x;
                if (IN_F32) x = xf[k][j]; else x = (f32x4){bflo(hw[k][j].x), bfhi(hw[k][j].x), bflo(hw[k][j].y), bfhi(hw[k][j].y)};
                const f32x4 mv = {bflo(mw[k][j].x), bfhi(mw[k][j].x), bflo(mw[k][j].y), bfhi(mw[k][j].y)};
                const f32x4 hn = x + mv * rstd * w4[j];
                if (OUT_F32) __builtin_nontemporal_store(hn, (f32x4*)(hout32 + (size_t)row * DM) + lane + 64 * j);
                else { ss += dot4(hn); u32x2 w; w.x = pk2(hn[0], hn[1]); w.y = pk2(hn[2], hn[3]); hb[64 * j] = w; }
            }
            if (!OUT_F32) { ss = wave_sum(ss); if (lane == 0) P.SSQH()[row] = ss; } }
    }
}

constexpr int KPITCH = 208, VPITCH = 144, ATT_KBUF = 64 * KPITCH, ATT_VBUF = 64 * VPITCH, ATT_BUF = ATT_KBUF + ATT_VBUF;
#define MFMA32(a, b, c) __builtin_amdgcn_mfma_f32_32x32x16_bf16(a, b, c, 0, 0, 0)
#define MFMA16(a, b, c) __builtin_amdgcn_mfma_f32_16x16x32_bf16(a, b, c, 0, 0, 0)

__device__ __forceinline__ float max3f(float a, float b, float c) { float r; asm("v_max3_f32 %0, %1, %2, %3" : "=v"(r) : "v"(a), "v"(b), "v"(c)); return r; }
__device__ __forceinline__ float max2f(float a, float b) { float r; asm("v_max_f32_e32 %0, %1, %2" : "=v"(r) : "v"(a), "v"(b)); return r; }
constexpr float ATT_THR = 8.f;
__device__ __forceinline__ void attn_unit(LAS unsigned char* lds, const WsPtrs& P, int b, int h, int qb) {
    const int tid = tid_opaque(), lane = tid & 63, w = __builtin_amdgcn_readfirstlane(tid >> 6), r32 = lane & 31, hi = lane >> 5;
    const int q0 = qb * 256, ntw = 4 * qb + (w >> 1) + 1, NT = 4 * qb + 4;
    const size_t tokb = (size_t)b * SEQ;
    bf16x8 qf[6];
    { const bf16_t* qp = P.Q() + (tokb + q0 + 32 * w + r32) * 768 + h * 96 + 8 * hi;
#pragma unroll
      for (int s = 0; s < 6; ++s) qf[s] = *(const bf16x8*)(qp + 16 * s); }
    const int kr = tid >> 3, kc = tid & 7, rr = (tid >> 2) & 63, rc = tid & 3;
    const char* kbase = (const char*)(P.KN() + tokb * 512 + h * 64);
    const char* rbase = (const char*)(P.KR() + tokb * 32);
    const char* vbase = (const char*)(P.VT() + ((size_t)((b * 8 + h) * 64)) * SEQ);
    const unsigned koff = (unsigned)(kr * 512 + kc * 8) * 2u, roff = (unsigned)(rr * 32 + rc * 8) * 2u, voff = (unsigned)(kr * SEQ + kc * 8) * 2u;
    const int kdst = kr * KPITCH + kc * 16, rdst = rr * KPITCH + 128 + rc * 16, vdst = ATT_KBUF + kr * VPITCH + (kc >> 1) * 32 + (kc & 1) * 8;
    const int kfo = r32 * KPITCH + hi * 16, vfo = ATT_KBUF + r32 * VPITCH + hi * 16;
    u32x4 kregX, rregX = {0u, 0u, 0u, 0u}, vregX, kregY, rregY = {0u, 0u, 0u, 0u}, vregY;
#define ATT_GLOAD(S, t) do { kreg##S = *(const u32x4*)(kbase + (size_t)(t) * (64 * 512 * 2) + koff); rreg##S = *(const u32x4*)(rbase + (size_t)(t) * (64 * 32 * 2) + roff); vreg##S = *(const u32x4*)(vbase + (size_t)(t) * (64 * 2) + voff); } while (0)
#define ATT_LSTORE(S, boff) do { LAS unsigned char* bb = lds + (boff); *(LAS u32x4*)(bb + kdst) = kreg##S; if (w < 4) *(LAS u32x4*)(bb + rdst) = rreg##S;   \
        *(LAS u32x2*)(bb + vdst) = (u32x2){vreg##S.x, vreg##S.y}; *(LAS u32x2*)(bb + vdst + 16) = (u32x2){vreg##S.z, vreg##S.w}; } while (0)
#define ATT_BAR() do { asm volatile("s_waitcnt lgkmcnt(0)" ::: "memory"); __builtin_amdgcn_s_barrier(); asm volatile("" ::: "memory"); } while (0)
#define ATT_QK(P0, P1, boff) do { const LAS unsigned char* kb_ = lds + (boff) + kfo; \
        { const bf16x8 k0 = *(const LAS bf16x8*)(kb_); const bf16x8 k1 = *(const LAS bf16x8*)(kb_ + 32 * KPITCH); P0 = MFMA32(k0, qf[0], negm); P1 = MFMA32(k1, qf[0], negm); } \
        _Pragma("unroll") for (int s_ = 1; s_ < 6; ++s_) { const bf16x8 k0 = *(const LAS bf16x8*)(kb_ + s_ * 32); const bf16x8 k1 = *(const LAS bf16x8*)(kb_ + 32 * KPITCH + s_ * 32); \
            P0 = MFMA32(k0, qf[s_], P0); P1 = MFMA32(k1, qf[s_], P1); } } while (0)
#define ATT_SM1(P0, P1, MREF) do { \
        float rm = max2f(P0[0], P1[0]), rm2_ = max2f(P0[1], P1[1]); \
        _Pragma("unroll") for (int r_ = 2; r_ < 16; r_ += 2) { rm = max3f(rm, P0[r_], P1[r_]); rm2_ = max3f(rm2_, P0[r_ + 1], P1[r_ + 1]); } \
        rm = max2f(rm, rm2_); \
        { auto sw_ = __builtin_amdgcn_permlane32_swap(__float_as_uint(rm), __float_as_uint(rm), false, false); rm = max2f(__uint_as_float(sw_[0]), __uint_as_float(sw_[1])); } \
        const bool need_ = ((MREF) + rm > mrun + ATT_THR) || ((MREF) != mrun); \
        if (__builtin_amdgcn_ballot_w64(need_) != 0ull) { \
            const float mn_ = fmaxf(mrun, (MREF) + rm), alpha_ = __builtin_amdgcn_exp2f(mrun - mn_), sub_ = mn_ - (MREF); \
            lrun *= alpha_; \
            _Pragma("unroll") for (int r_ = 0; r_ < 16; ++r_) { ot0[r_] *= alpha_; ot1[r_] *= alpha_; P0[r_] -= sub_; P1[r_] -= sub_; } \
            mrun = mn_; mcin = mn_; \
            _Pragma("unroll") for (int r_ = 0; r_ < 16; ++r_) negm[r_] = -mn_; \
            asm volatile("" : "+v"(negm)); } } while (0)
#define ATT_SM2(P0, P1) do { \
        f32x2_t sa_ = {0.f, 0.f}, sb_ = {0.f, 0.f}; \
        _Pragma("unroll") for (int r_ = 0; r_ < 16; r_ += 2) { P0[r_] = __builtin_amdgcn_exp2f(P0[r_]); P0[r_ + 1] = __builtin_amdgcn_exp2f(P0[r_ + 1]); P1[r_] = __builtin_amdgcn_exp2f(P1[r_]); P1[r_ + 1] = __builtin_amdgcn_exp2f(P1[r_ + 1]); \
            sa_ += (f32x2_t){P0[r_], P0[r_ + 1]}; sb_ += (f32x2_t){P1[r_], P1[r_ + 1]}; } \
        sa_ += sb_; lrun += sa_.x + sa_.y; } while (0)
#define ATT_PV(P0, P1, boff) do { \
        u32x4 pw_[4]; \
        _Pragma("unroll") for (int j_ = 0; j_ < 4; ++j_) { pw_[0][j_] = pk2(P0[2 * j_], P0[2 * j_ + 1]); pw_[1][j_] = pk2(P0[8 + 2 * j_], P0[9 + 2 * j_]); pw_[2][j_] = pk2(P1[2 * j_], P1[2 * j_ + 1]); pw_[3][j_] = pk2(P1[8 + 2 * j_], P1[9 + 2 * j_]); } \
        const LAS unsigned char* vb_ = lds + (boff) + vfo; \
        _Pragma("unroll") for (int ks_ = 0; ks_ < 4; ++ks_) { \
            const bf16x8 pa_ = __builtin_bit_cast(bf16x8, pw_[ks_]); \
            const bf16x8 vf0 = *(const LAS bf16x8*)(vb_ + ks_ * 32); \
            const bf16x8 vf1 = *(const LAS bf16x8*)(vb_ + 32 * VPITCH + ks_ * 32); \
            ot0 = MFMA32(vf0, pa_, ot0); ot1 = MFMA32(vf1, pa_, ot1); } } while (0)
#define ATT_ROT() do { const int t_ = bc; bc = bn; bn = bnn; bnn = b3; b3 = t_; } while (0)
    if (w < 4) __builtin_amdgcn_s_setprio(1);
    float mrun = -1e30f, lrun = 0.f, mcin = 0.f, mrefA = 0.f, mrefB = 0.f;
    f32x16 ot0 = {}, ot1 = {}, negm = {};
    asm volatile("" : "+v"(negm));
    f32x16 pA0, pA1, pB0, pB1;
    { u32x4 kregZ, rregZ, vregZ;
      ATT_GLOAD(X, 0); ATT_GLOAD(Y, 1); ATT_GLOAD(Z, 2); ATT_LSTORE(X, 0); ATT_LSTORE(Y, ATT_BUF); ATT_LSTORE(Z, 2 * ATT_BUF); }
    ATT_GLOAD(Y, 3); ATT_BAR();
    ATT_QK(pA0, pA1, 0); mrefA = mcin;
    asm volatile("s_nop 15\n\ts_nop 15" : "+v"(pA0), "+v"(pA1));
    if (w >= 4) ATT_BAR();
#define ATT_STEP(PN0, PN1, MREFN, PC0, PC1, MREFC, tt, LS, SS, BC, BN, B3) do {   \
        { const int tl_ = (tt) + 4 < NT ? (tt) + 4 : NT - 1; ATT_GLOAD(LS, tl_); }   \
        if ((tt) < ntw) { ATT_SM1(PC0, PC1, MREFC); __builtin_amdgcn_sched_barrier(0); ATT_QK(PN0, PN1, (BN) * ATT_BUF); MREFN = mcin; ATT_SM2(PC0, PC1); }   \
        ATT_BAR(); \
        if ((tt) < ntw) { ATT_PV(PC0, PC1, (BC) * ATT_BUF); } \
        ATT_LSTORE(SS, (B3) * ATT_BUF); \
        ATT_BAR(); } while (0)
    for (int t = 0; t < NT; t += 4) {
        ATT_STEP(pB0, pB1, mrefB, pA0, pA1, mrefA, t, X, Y, 0, 1, 3);
        ATT_STEP(pA0, pA1, mrefA, pB0, pB1, mrefB, t + 1, Y, X, 1, 2, 0);
        ATT_STEP(pB0, pB1, mrefB, pA0, pA1, mrefA, t + 2, X, Y, 2, 3, 1);
        ATT_STEP(pA0, pA1, mrefA, pB0, pB1, mrefB, t + 3, Y, X, 3, 0, 2);
    }
    if (w < 4) ATT_BAR();
#undef ATT_STEP
    __builtin_amdgcn_s_setprio(0);
    lrun += __shfl_xor(lrun, 32);
    const float inv = 1.f / lrun;
    bf16_t* yp = P.Y() + (tokb + q0 + 32 * w + r32) * 1024 + h * 64 + 4 * hi;
#pragma unroll
    for (int g = 0; g < 4; ++g) {
        st_bf4(yp + 8 * g, (f32x4){ot0[4 * g] * inv, ot0[4 * g + 1] * inv, ot0[4 * g + 2] * inv, ot0[4 * g + 3] * inv});
        st_bf4(yp + 32 + 8 * g, (f32x4){ot1[4 * g] * inv, ot1[4 * g + 1] * inv, ot1[4 * g + 2] * inv, ot1[4 * g + 3] * inv});
    }
#undef ATT_GLOAD
#undef ATT_LSTORE
#undef ATT_QK
#undef ATT_SM1
#undef ATT_SM2
#undef ATT_PV
#undef ATT_ROT
#undef ATT_BAR
}

constexpr int SL_ACS = 0, SL_DTL = 1024, SL_SSQ = 2048, SL_XT = 4096  , XR_PITCH = 544, SL_B = SL_XT + 36864  , BC_PITCH = 272, B1_PITCH = 288  ,
              SL_C = SL_B + 18432  , SL_S = SL_C + 64 * BC_PITCH  , S_PITCH = 144, S_HEAD = 64 * S_PITCH, SL_END = SL_S + 4 * S_HEAD;
static_assert(SL_END <= 131072 && 64 * XR_PITCH <= 36864 && 64 * B1_PITCH <= 18432, "ssd lds");
typedef short v4i16_t __attribute__((ext_vector_type(4)));
__device__ __forceinline__ bf16x8 tr_frag(const LAS unsigned char* img, int pitch, int k0, int colbyte0, int lane) {
    const int g = lane >> 4, q = (lane & 15) >> 2, p = lane & 3;
    const LAS unsigned char* a = img + (k0 + 8 * g + q) * pitch + colbyte0 + p * 8;
    const v4i16_t lo = __builtin_amdgcn_ds_read_tr16_b64_v4i16((LAS v4i16_t*)a), hi = __builtin_amdgcn_ds_read_tr16_b64_v4i16((LAS v4i16_t*)(a + 4 * pitch));
    return (bf16x8){lo[0], lo[1], lo[2], lo[3], hi[0], hi[1], hi[2], hi[3]};
}

__device__ __forceinline__ void ssd_scan_dt(LAS unsigned char* lds, const WsPtrs& P, const float* a_log, size_t t0, int g, int bc, bool write_cdec) {
    const int tid = tid_opaque(), lane = tid & 63, w = __builtin_amdgcn_readfirstlane(tid >> 6);
    if (w < 4) {
        const int head = 4 * g + w;
        const float dtv = P.DT()[(t0 + lane) * 8 + head];
        float a = -dtv * __expf(a_log[head]);
#pragma unroll
        for (int off = 1; off < 64; off <<= 1) { const float t = __shfl_up(a, off); if (lane >= off) a += t; }
        ((LAS float*)(lds + SL_ACS))[w * 64 + lane] = a; ((LAS float*)(lds + SL_DTL))[w * 64 + lane] = dtv;
        if (write_cdec && lane == 63) P.CDEC()[(size_t)bc * 8 + head] = __expf(a);
    }
}

#define SSD_BAR() do { asm volatile("s_waitcnt lgkmcnt(0)" ::: "memory"); __builtin_amdgcn_s_barrier(); asm volatile("" ::: "memory"); } while (0)
struct ConvIn { float wk[4][8]; float bs[8]; u32x4 raw[11]; };
__device__ __forceinline__ void ssd_conv_load(ConvIn& ci, const WsPtrs& P, const float* cw, const float* cb, size_t t0, int c, int g, int tid) {
    const int cg_ = tid & 63, rb = tid >> 6;
    const int col = cg_ < 32 ? g * 256 + cg_ * 8 : (cg_ < 48 ? 512 + g * 128 + (cg_ - 32) * 8 : 768 + g * 128 + (cg_ - 48) * 8);
    const bf16_t* src = P.XBC() + t0 * 1024 + col;
#pragma unroll
    for (int i = 0; i < 11; ++i) { const int lr = 8 * rb - 3 + i;
        if (lr < 0 && c == 0) ci.raw[i] = (u32x4){0u, 0u, 0u, 0u}; else ci.raw[i] = *(const u32x4*)(src + (ptrdiff_t)lr * 1024); }
#pragma unroll
    for (int k = 0; k < 4; ++k) { const f32x4 a = *(const f32x4*)(cw + k * 1024 + col), b2 = *(const f32x4*)(cw + k * 1024 + col + 4);
#pragma unroll
        for (int e = 0; e < 4; ++e) { ci.wk[k][e] = a[e]; ci.wk[k][4 + e] = b2[e]; } }
    { const f32x4 a = *(const f32x4*)(cb + col), b2 = *(const f32x4*)(cb + col + 4);
#pragma unroll
      for (int e = 0; e < 4; ++e) { ci.bs[e] = a[e]; ci.bs[4 + e] = b2[e]; } }
}
template <int MODE>
__device__ __forceinline__ void ssd_conv_compute(const ConvIn& ci, LAS unsigned char* lds, int tid) {
    const int cg_ = tid & 63, rb = tid >> 6;
    if (MODE == 1 && cg_ >= 48) return;
    const LAS float* ACS = (const LAS float*)(lds + SL_ACS); const LAS float* DTL = (const LAS float*)(lds + SL_DTL);
    const int hh = cg_ >> 3;
    LAS unsigned char* base; int pitch;
    if (cg_ < 32) { base = lds + SL_XT + cg_ * 16; pitch = XR_PITCH; }
    else if (cg_ < 48) { base = lds + SL_B + (cg_ - 32) * 16; pitch = (MODE == 1) ? B1_PITCH : BC_PITCH; }
    else { base = lds + SL_C + (cg_ - 48) * 16; pitch = BC_PITCH; }
#pragma unroll
    for (int r = 0; r < 8; ++r) {
        const int s0 = 8 * rb + r;
        float o[8];
#pragma unroll
        for (int e2 = 0; e2 < 4; ++e2) {
            f32x2_t a2 = {ci.bs[2 * e2], ci.bs[2 * e2 + 1]};
#pragma unroll
            for (int k = 0; k < 4; ++k) { const unsigned wd = ci.raw[r + k][e2]; const f32x2_t x2 = {bflo(wd), bfhi(wd)}; const f32x2_t w2 = {ci.wk[k][2 * e2], ci.wk[k][2 * e2 + 1]}; a2 = x2 * w2 + a2; }
            const f32x2_t n2 = a2 * (-1.4426950408889634f);
            f32x2_t d2; d2.x = __builtin_amdgcn_exp2f(n2.x); d2.y = __builtin_amdgcn_exp2f(n2.y); d2 = d2 + 1.0f;
            f32x2_t r2; r2.x = __builtin_amdgcn_rcpf(d2.x); r2.y = __builtin_amdgcn_rcpf(d2.y);
            const f32x2_t o2 = a2 * r2; o[2 * e2] = o2.x; o[2 * e2 + 1] = o2.y;
        }
        float wgt = 1.f;
        if (MODE == 1 && cg_ < 32) wgt = DTL[hh * 64 + s0] * __expf(ACS[hh * 64 + 63] - ACS[hh * 64 + s0]);
        *(LAS u32x4*)(base + s0 * pitch) = (u32x4){pk2(o[0] * wgt, o[1] * wgt), pk2(o[2] * wgt, o[3] * wgt), pk2(o[4] * wgt, o[5] * wgt), pk2(o[6] * wgt, o[7] * wgt)};
    }
}

__device__ __forceinline__ void ssd_s1_unit(LAS unsigned char* lds, const WsPtrs& P, const float* cw, const float* cb, const float* a_log, int u) {
    const int g = u & 1, c = (u >> 1) & 127, b = u >> 8;
    const int tid = tid_opaque(), lane = tid & 63, w = __builtin_amdgcn_readfirstlane(tid >> 6), r = lane & 15, q4 = lane >> 4;
    const size_t t0 = (size_t)b * SEQ + c * 64;
    ConvIn ci; ssd_conv_load(ci, P, cw, cb, t0, c, g, tid);
    ssd_scan_dt(lds, P, a_log, t0, g, b * NCHUNK + c, true);
    __syncthreads();
    ssd_conv_compute<1>(ci, lds, tid);
    __syncthreads();
    const int hh = w >> 1;
    bf16_t* sb = P.STATES() + ((size_t)((b * NCHUNK + c) * 8 + 4 * g + hh)) * 64 * 128;
#pragma unroll
    for (int pt2 = 0; pt2 < 2; ++pt2) {
        const int pt = 2 * (w & 1) + pt2;
        bf16x8 xb[2];
#pragma unroll
        for (int ks = 0; ks < 2; ++ks) xb[ks] = tr_frag(lds + SL_XT, XR_PITCH, 32 * ks, (hh * 64 + 16 * pt) * 2, lane);
#pragma unroll
        for (int nt = 0; nt < 8; ++nt) {
            f32x4 acc = {0.f, 0.f, 0.f, 0.f};
#pragma unroll
            for (int ks = 0; ks < 2; ++ks) { const bf16x8 bt = tr_frag(lds + SL_B, B1_PITCH, 32 * ks, (16 * nt) * 2, lane); acc = MFMA16(bt, xb[ks], acc); }
            st_bf4(sb + (size_t)(16 * pt + r) * 128 + 16 * nt + 4 * q4, acc);
        }
    }
    SSD_BAR();
}

__device__ __forceinline__ void ssd_s2(const WsPtrs& P, int vcu, int G) {
    for (int e = vcu * 512 + tid_opaque(); e < BATCH * 8 * 64 * 32; e += G * 512) {
        const int n4 = e & 31, pp = (e >> 5) & 63, h = (e >> 11) & 7, b = e >> 14;
        bf16_t* base = P.STATES() + ((size_t)(b * NCHUNK) * 8 + h) * 8192 + pp * 128 + n4 * 4;
        const float* dec = P.CDEC() + (size_t)(b * NCHUNK) * 8 + h;
        float h0 = 0.f, h1 = 0.f, h2 = 0.f, h3 = 0.f;
        for (int c0 = 0; c0 < NCHUNK; c0 += 16) {
            u32x2 st[16]; float d[16];
#pragma unroll
            for (int i = 0; i < 16; ++i) { st[i] = *(const u32x2*)(base + (size_t)(c0 + i) * 65536); d[i] = dec[(c0 + i) * 8]; }
            asm volatile("" ::: "memory");
#pragma unroll
            for (int i = 0; i < 16; ++i) {
                u32x2 o; o.x = pk2(h0, h1); o.y = pk2(h2, h3); *(u32x2*)(base + (size_t)(c0 + i) * 65536) = o;
                h0 = h0 * d[i] + bflo(st[i].x); h1 = h1 * d[i] + bfhi(st[i].x); h2 = h2 * d[i] + bflo(st[i].y); h3 = h3 * d[i] + bfhi(st[i].y);
            }
            asm volatile("" ::: "memory");
        }
    }
}

__device__ __forceinline__ void ssd_s3_unit(LAS unsigned char* lds, const WsPtrs& P, const float* cw, const float* cb, const float* a_log, const float* dskip, const float* nrm, int u) {
    const int g = u & 1, c = (u >> 1) & 127, b = u >> 8;
    const int tid = tid_opaque(), lane = tid & 63, w = __builtin_amdgcn_readfirstlane(tid >> 6), r = lane & 15, q4 = lane >> 4;
    const size_t t0 = (size_t)b * SEQ + c * 64;
    ConvIn ci; ssd_conv_load(ci, P, cw, cb, t0, c, g, tid);
    u32x2 zw[2][4];
    { const int hh_ = w >> 1;
#pragma unroll
      for (int a = 0; a < 2; ++a)
#pragma unroll
          for (int pt = 0; pt < 4; ++pt) zw[a][pt] = *(const u32x2*)(P.Z() + (t0 + 16 * (2 * (w & 1) + a) + r) * 512 + (4 * g + hh_) * 64 + 16 * pt + 4 * q4); }
    ssd_scan_dt(lds, P, a_log, t0, g, 0, false);
    __syncthreads();
    ssd_conv_compute<3>(ci, lds, tid);
    bf16x8 pvf[4][4];
    { const bf16_t* pb = P.STATES() + ((size_t)((b * NCHUNK + c) * 8 + 4 * g + (w >> 1))) * 8192;
#pragma unroll
      for (int ks = 0; ks < 4; ++ks)
#pragma unroll
          for (int pt = 0; pt < 4; ++pt) pvf[ks][pt] = *(const bf16x8*)(pb + (size_t)(16 * pt + r) * 128 + ks * 32 + q4 * 8); }
    __syncthreads();
    const LAS float* ACS = (const LAS float*)(lds + SL_ACS); const LAS float* DTL = (const LAS float*)(lds + SL_DTL);
    {
        const int lt = w >> 1;
#pragma unroll
        for (int s2 = 0; s2 < 2; ++s2) {
            const int st = 2 * (w & 1) + s2;
            f32x4 gacc = {0.f, 0.f, 0.f, 0.f};
            if (st <= lt) {
#pragma unroll
                for (int ks = 0; ks < 4; ++ks) {
                    const bf16x8 ca = *(const LAS bf16x8*)(lds + SL_C + (16 * lt + r) * BC_PITCH + ks * 64 + q4 * 16);
                    const bf16x8 bb = *(const LAS bf16x8*)(lds + SL_B + (16 * st + r) * BC_PITCH + ks * 64 + q4 * 16);
                    gacc = MFMA16(bb, ca, gacc);
                }
            }
            const int l = 16 * lt + r, sb = 16 * st + 4 * q4;
#pragma unroll
            for (int hh = 0; hh < 4; ++hh) {
                const float al = ACS[hh * 64 + l];
                const f32x4 as = *(const LAS f32x4*)(ACS + hh * 64 + sb), ds = *(const LAS f32x4*)(DTL + hh * 64 + sb);
                f32x4 v;
#pragma unroll
                for (int i = 0; i < 4; ++i) v[i] = (l >= sb + i) ? gacc[i] * __expf(al - as[i]) * ds[i] : 0.f;
                *(LAS u32x2*)(lds + SL_S + hh * S_HEAD + l * S_PITCH + sb * 2) = (u32x2){pk2(v[0], v[1]), pk2(v[2], v[3])};
            }
        }
    }
    __syncthreads();
    const int hh = w >> 1, head = 4 * g + hh;
    f32x4 acc[2][4];
#pragma unroll
    for (int a = 0; a < 2; ++a)
#pragma unroll
        for (int pt = 0; pt < 4; ++pt) acc[a][pt] = (f32x4){0.f, 0.f, 0.f, 0.f};
    {
#pragma unroll
        for (int ks = 0; ks < 4; ++ks) {
            bf16x8 ca[2];
#pragma unroll
            for (int a = 0; a < 2; ++a) ca[a] = *(const LAS bf16x8*)(lds + SL_C + (16 * (2 * (w & 1) + a) + r) * BC_PITCH + ks * 64 + q4 * 16);
#pragma unroll
            for (int pt = 0; pt < 4; ++pt) {
                const bf16x8 pv = pvf[ks][pt];
#pragma unroll
                for (int a = 0; a < 2; ++a) acc[a][pt] = MFMA16(pv, ca[a], acc[a][pt]);
            }
        }
#pragma unroll
        for (int a = 0; a < 2; ++a) {
            const float sc = __expf(ACS[hh * 64 + 16 * (2 * (w & 1) + a) + r]);
#pragma unroll
            for (int pt = 0; pt < 4; ++pt) acc[a][pt] *= sc;
        }
    }
#pragma unroll
    for (int ks = 0; ks < 2; ++ks) {
        bf16x8 sa[2];
#pragma unroll
        for (int a = 0; a < 2; ++a) sa[a] = *(const LAS bf16x8*)(lds + SL_S + hh * S_HEAD + (16 * (2 * (w & 1) + a) + r) * S_PITCH + ks * 64 + q4 * 16);
#pragma unroll
        for (int pt = 0; pt < 4; ++pt) {
            const bf16x8 xb = tr_frag(lds + SL_XT, XR_PITCH, 32 * ks, (hh * 64 + 16 * pt) * 2, lane);
#pragma unroll
            for (int a = 0; a < 2; ++a) acc[a][pt] = MFMA16(xb, sa[a], acc[a][pt]);
        }
    }
    const float dsk = dskip[head];
#pragma unroll
    for (int a = 0; a < 2; ++a) {
        const int l = 16 * (2 * (w & 1) + a) + r;
        float ssq = 0.f;
#pragma unroll
        for (int pt = 0; pt < 4; ++pt) {
            const int p0 = 16 * pt + 4 * q4;
            const float zv[4] = {bflo(zw[a][pt].x), bfhi(zw[a][pt].x), bflo(zw[a][pt].y), bfhi(zw[a][pt].y)};
            const u32x2 xw = *(const LAS u32x2*)(lds + SL_XT + l * XR_PITCH + (hh * 64 + p0) * 2);
            const float xq[4] = {bflo(xw.x), bfhi(xw.x), bflo(xw.y), bfhi(xw.y)};
#pragma unroll
            for (int i = 0; i < 4; ++i) {
                const float xv = xq[i];
                const float y = (acc[a][pt][i] + dsk * xv) * siluf(zv[i]);
                acc[a][pt][i] = y; ssq += y * y;
            }
        }
        ssq += __shfl_xor(ssq, 16); ssq += __shfl_xor(ssq, 32);
        if (q4 == 0) ((LAS float*)(lds + SL_SSQ))[hh * 64 + l] = ssq;
    }
    __syncthreads();
    {
        const LAS float* SQ = (const LAS float*)(lds + SL_SSQ);
#pragma unroll
        for (int a = 0; a < 2; ++a) {
            const int l = 16 * (2 * (w & 1) + a) + r;
            const float rstd = rsqrtf(((SQ[l] + SQ[64 + l]) + (SQ[128 + l] + SQ[192 + l])) * (1.f / 256.f) + EPS);
#pragma unroll
            for (int pt = 0; pt < 4; ++pt) {
                const int ch = head * 64 + 16 * pt + 4 * q4;
                const f32x4 nw = *(const f32x4*)(nrm + ch);
                st_bf4(P.Y() + (t0 + l) * 1024 + 512 + ch, acc[a][pt] * rstd * nw);
            }
        }
    }
    SSD_BAR();
}

#define XB_TMO      128
#define XB_XCNT(j)  (256  + 64 * (j))
#define XB_XSUB(j)  (1280 + 64 * (j))
#define XB_XGEN(j)  (2304 + 64 * (j))
#define XB_TOP      3328
#define XB_TOPGEN   3392
#define XCD_BAR_WORDS 3456
#define XB_SPIN_CAP (1u << 21)
__device__ __forceinline__ unsigned xb_ld(unsigned* p)              { return __hip_atomic_load(p, __ATOMIC_RELAXED, __HIP_MEMORY_SCOPE_AGENT); }
__device__ __forceinline__ unsigned xb_add(unsigned* p, unsigned v) { return __hip_atomic_fetch_add(p, v, __ATOMIC_RELAXED, __HIP_MEMORY_SCOPE_AGENT); }
__device__ __forceinline__ unsigned xb_xcc_id() { return (unsigned)__builtin_amdgcn_s_getreg((3 << 11) | 20) & 0xFu; }
#define XB_SPIN(cond, bar) do { unsigned _sp = 0; while (cond) { __builtin_amdgcn_s_sleep(1); \
    if ((++_sp & 255u) == 0u) { if (xb_ld(&(bar)[XB_TMO])) break; if (_sp > XB_SPIN_CAP) { atomicAdd(&(bar)[XB_TMO], 1u); break; } } } } while (0)
struct XcdBarrier { unsigned* bar; unsigned x; volatile LAS unsigned* st; };
__device__ __forceinline__ XcdBarrier xcd_barrier_post(unsigned* bar, volatile LAS unsigned* st) {
    XcdBarrier b; b.bar = bar; b.x = xb_xcc_id(); b.st = st;
    if (threadIdx.x == 0) (void)xb_add(&bar[XB_XCNT(b.x)], 1u);
    return b;
}
__device__ __forceinline__ void xcd_barrier_complete(unsigned* bar, unsigned x, unsigned& nloc, unsigned& nx) {
    const unsigned G = gridDim.x * gridDim.y * gridDim.z;
    unsigned sum, cnt, mine, sp = 0u;
    for (;;) {
        sum = 0u; cnt = 0u; mine = 0u;
#pragma unroll
        for (unsigned j = 0; j < 16; ++j) { const unsigned c = xb_ld(&bar[XB_XCNT(j)]); sum += c; cnt += (c > 0u) ? 1u : 0u; mine = (j == x) ? c : mine; }
        if (sum == G) break;
        __builtin_amdgcn_s_sleep(1);
        if ((++sp & 255u) == 0u) { if (xb_ld(&bar[XB_TMO])) break; if (sp > XB_SPIN_CAP) { atomicAdd(&bar[XB_TMO], 1u); break; } }
    }
    nloc = mine > 0u ? mine : 1u; nx = cnt > 0u ? cnt : 1u;
}
__device__ __forceinline__ void xcd_barrier(const XcdBarrier& b) {
    asm volatile("s_waitcnt vmcnt(0)" ::: "memory");
    __syncthreads();
    if (threadIdx.x == 0) {
        unsigned* bar = b.bar;
        __builtin_amdgcn_s_waitcnt(0);
        unsigned nloc = b.st[0], nx = b.st[1];
        if (nloc == 0u) { xcd_barrier_complete(bar, b.x, nloc, nx); b.st[0] = nloc; b.st[1] = nx; }
        const unsigned old = xb_add(&bar[XB_XSUB(b.x)], 1u);
        const unsigned gen = old / nloc;
        if (old + 1u == (gen + 1u) * nloc) {
            __builtin_amdgcn_fence(__ATOMIC_RELEASE, "agent");
            asm volatile("s_waitcnt vmcnt(0)" ::: "memory");
            const unsigned og = xb_add(&bar[XB_TOP], 1u);
            const unsigned tg = og / nx;
            if (og + 1u == (tg + 1u) * nx) xb_add(&bar[XB_TOPGEN], 1u);
            else XB_SPIN(xb_ld(&bar[XB_TOPGEN]) == tg, bar);
            __builtin_amdgcn_fence(__ATOMIC_ACQUIRE, "agent");
            xb_add(&bar[XB_XGEN(b.x)], 1u);
            asm volatile("s_waitcnt vmcnt(0)" ::: "memory");
        } else {
            XB_SPIN(xb_ld(&bar[XB_XGEN(b.x)]) == gen, bar);
            __builtin_amdgcn_fence(__ATOMIC_ACQUIRE, "agent");
            asm volatile("s_waitcnt vmcnt(0)" ::: "memory");
        }
    }
    __syncthreads();
}

constexpr int PH_PER_LAYER = 9, N_PHASES = 1 + NLAYER * PH_PER_LAYER;

#define PH_BEGIN(k) if (ph_lo <= (k) && (k) < ph_hi) { KP pk = kargs(); WsPtrs P; P.ws = pk->ws; int G = gridDim.x, bx = blockIdx.x; asm volatile("" : "+s"(G), "+s"(bx)); \
        const int vcu = (G % 8 == 0) ? (bx % 8) * (G / 8) + bx / 8 : bx; (void)vcu; (void)bx;
#define PH_END(k) if ((k) + 1 < ph_hi) { if ((k) == 0) cg::this_grid().sync(); else xcd_barrier(xb); } }

__device__ __forceinline__ void run_layer(const int l, const int pb, const int ph_lo, const int ph_hi, LAS unsigned char* lds, const XcdBarrier& xb) {
    PH_BEGIN(pb + 0) {
        unsigned char* wb = P.ws + (size_t)l * W_LSTRIDE;
        pg8::Gemm g{P.HB(), (const bf16_t*)(wb + W_IN), T, NPROJ, 1024}; pg8::StaticOrder S; S.init(T, NPROJ, G, bx);
        Epi<M_INPROJ> E{P, pk->in[10] + l * 8, nullptr};
        pg8::gemm_phase<Epi<M_INPROJ>, pg8::StaticOrder, true, true>(lds, g, S, E);
    } PH_END(pb + 0)
    PH_BEGIN(pb + 1) {
        unsigned char* wb = P.ws + (size_t)l * W_LSTRIDE;
        pg8::Gemm g{P.CQ(), (const bf16_t*)(wb + W_UQ), T, 768, 768}; pg8::StaticOrder S; S.init(T, 768, G, bx);
        Epi<M_Q> E{P, nullptr, nullptr}; pg8::gemm_phase<Epi<M_Q>, pg8::StaticOrder, true, true>(lds, g, S, E);
    } }
    PH_BEGIN(pb + 1) {
        unsigned char* wb = P.ws + (size_t)l * W_LSTRIDE;
        pg8::Gemm g{P.CKV(), (const bf16_t*)(wb + W_UKV), T, 1024, 256}; pg8::StaticOrder S; S.init(T, 1024, G, bx);
        Epi<M_KV> E{P, nullptr, nullptr}; pg8::gemm_phase<Epi<M_KV>, pg8::StaticOrder, true, true>(lds, g, S, E);
    } }
    PH_BEGIN(pb + 1) {
        for (int u = vcu; u < BATCH * NCHUNK * 2; u += G) ssd_s1_unit(lds, P, pk->in[8] + l * 4096, pk->in[9] + l * 1024, pk->in[11] + l * 8, u);
    } PH_END(pb + 1)
    PH_BEGIN(pb + 2) {
        ssd_s2(P, vcu, G);
    } }
    PH_BEGIN(pb + 2) {
        for (int u = vcu + ((2047 - vcu) / G) * G; u >= 0; u -= G) { const int i = u >> 8, vv = u & 255, bh = vv >> 2, s = vv & 3, j = i >> 1;
            const int qb = (i & 1) ? 8 * j + 7 - s : 8 * j + s;
            attn_unit(lds, P, bh >> 3, bh & 7, qb); }
    } PH_END(pb + 2)
    PH_BEGIN(pb + 3) {
        for (int u = vcu; u < BATCH * NCHUNK * 2; u += G) ssd_s3_unit(lds, P, pk->in[8] + l * 4096, pk->in[9] + l * 1024, pk->in[11] + l * 8, pk->in[12] + l * 8, pk->in[13] + l * 512, u);
    } PH_END(pb + 3)
    PH_BEGIN(pb + 4) {
        unsigned char* wb = P.ws + (size_t)l * W_LSTRIDE;
        pg8::Gemm g{P.Y(), (const bf16_t*)(wb + W_OUT), T, 1024, 1024}; pg8::StaticOrder S; S.init(T, 1024, G, bx);
        Epi<M_OUT> E{P, nullptr, P.MIX()}; pg8::gemm_phase<Epi<M_OUT>, pg8::StaticOrder, true, true>(lds, g, S, E);
    } PH_END(pb + 4)
    PH_BEGIN(pb + 5) {
        phase_residual<false, false>(nullptr, nullptr, P.MIX(), pk->in[15] + l * 1024, P, vcu, G);
    } PH_END(pb + 5)
    PH_BEGIN(pb + 6) {
        unsigned char* wb = P.ws + (size_t)l * W_LSTRIDE;
        pg8::Gemm g{P.HB(), (const bf16_t*)(wb + W_UP), T, DFF, 1024}; pg8::StaticOrder S; S.init(T, DFF, G, bx);
        Epi<M_UP> E{P, nullptr, nullptr}; pg8::gemm_phase<Epi<M_UP>, pg8::StaticOrder, true, true>(lds, g, S, E);
    } PH_END(pb + 6)
    PH_BEGIN(pb + 7) {
        unsigned char* wb = P.ws + (size_t)l * W_LSTRIDE;
        pg8::Gemm g{P.HID(), (const bf16_t*)(wb + W_DN), T, 1024, DFF}; pg8::StaticOrder S; S.init(T, 1024, G, bx);
        Epi<M_OUT> E{P, nullptr, P.Y()}; pg8::gemm_phase<Epi<M_OUT>, pg8::StaticOrder, true, true>(lds, g, S, E);
    } PH_END(pb + 7)
    PH_BEGIN(pb + 8) {
        if (l == NLAYER - 1) phase_residual<false, true>(nullptr, pk->out, P.Y(), pk->in[19] + l * 1024, P, vcu, G);
        else phase_residual<false, false>(nullptr, nullptr, P.Y(), pk->in[19] + l * 1024, P, vcu, G);
    } PH_END(pb + 8)
}

__global__ void __launch_bounds__(512) fwd_kernel(Params p) {
    extern __shared__ __attribute__((aligned(16))) unsigned char lds_raw[];
    LAS unsigned char* lds = (LAS unsigned char*)lds_raw;
    const int ph_lo = p.ph_lo, ph_hi = p.ph_hi;
    { volatile LAS unsigned* misc = (volatile LAS unsigned*)(lds + LDS_MISC); if (threadIdx.x < 8) misc[threadIdx.x] = 0u; }
    __syncthreads();
    XcdBarrier xb; { KP pk0 = kargs(); xb = xcd_barrier_post((unsigned*)(pk0->ws + WS_BAR), (volatile LAS unsigned*)(lds + LDS_MISC)); }
    PH_BEGIN(0) {
        phase_prep(pk, P, lds, vcu, G);
    } PH_END(0)
    run_layer(0, 1, ph_lo, ph_hi, lds, xb);
    run_layer(1, 1 + PH_PER_LAYER, ph_lo, ph_hi, lds, xb);
}

extern "C" void kernel_launch(void* const* d_in, const int* in_sizes, int n_in, void* d_out, int out_size, void* d_ws, size_t ws_size, hipStream_t stream) {
    static int grid = 0;
    if (grid == 0) {
        if (n_in != 20 || out_size != T * DM || ws_size < WS_NEED) { fprintf(stderr, "kernel_launch: unexpected problem (n_in %d out %d ws %zu)\n", n_in, out_size, ws_size); grid = -1; return; }
        int dev = 0, cus = 0, per_cu = 0;
        hipGetDevice(&dev); hipDeviceGetAttribute(&cus, hipDeviceAttributeMultiprocessorCount, dev);
        if (hipFuncSetAttribute((const void*)fwd_kernel, hipFuncAttributeMaxDynamicSharedMemorySize, LDS_BYTES) != hipSuccess) { fprintf(stderr, "kernel_launch: hipFuncSetAttribute failed\n"); grid = -1; return; }
        if (hipOccupancyMaxActiveBlocksPerMultiprocessor(&per_cu, (const void*)fwd_kernel, 512, LDS_BYTES) != hipSuccess || per_cu < 1) { fprintf(stderr, "kernel_launch: occupancy query says %d\n", per_cu); per_cu = 1; }
        (void)hipGetLastError();
        grid = cus;
    }
    if (grid < 0) return;
    (void)hipMemsetAsync((char*)d_ws + WS_BAR, 0, 16384, stream);
    Params a{};
    for (int i = 0; i < 20; ++i) a.in[i] = (const float*)d_in[i];
    a.out = (float*)d_out; a.ws = (unsigned char*)d_ws;
#if MK_COOP
    a.ph_lo = 0; a.ph_hi = N_PHASES;
    void* args[] = {&a};
    hipError_t e = hipLaunchCooperativeKernel((const void*)fwd_kernel, dim3(grid), dim3(512), args, LDS_BYTES, stream);
    if (e != hipSuccess) fprintf(stderr, "cooperative launch failed: %s (grid %d)\n", hipGetErrorString(e), grid);
#else
    for (int ph = 0; ph < N_PHASES; ++ph) {
        a.ph_lo = ph; a.ph_hi = ph + 1;
        hipLaunchKernelGGL(fwd_kernel, dim3(grid), dim3(512), LDS_BYTES, stream, a);
    }
#endif
}
```

```cpp
#include <hip/hip_runtime.h>
#include <hip/hip_cooperative_groups.h>
#include <cstdio>
#include <cstdint>
namespace cg = cooperative_groups;

#ifndef MK_COOP
#define MK_COOP 1
#endif

#ifndef PH_MASK
#define PH_MASK 0x1fff
#endif
#define LAS __attribute__((address_space(3)))
typedef unsigned short bf16_t;
typedef short bf16x8 __attribute__((ext_vector_type(8)));
typedef short s16x4 __attribute__((ext_vector_type(4)));
typedef float f32x4 __attribute__((ext_vector_type(4)));
typedef float f32x16 __attribute__((ext_vector_type(16)));
typedef unsigned u32x4 __attribute__((ext_vector_type(4)));
typedef unsigned u32x2 __attribute__((ext_vector_type(2)));
typedef float f32x2_t __attribute__((ext_vector_type(2)));
typedef __bf16 bf16x2_t __attribute__((ext_vector_type(2)));

constexpr int BATCH = 8, SEQ = 8192, DM = 1024, T = BATCH * SEQ;
constexpr int NQL = 768, NKVL = 256, NPROJ_SRC = 2600, NPROJ = 2816, DFF = 4096;
constexpr int NLAYER = 2;
constexpr float EPS = 1e-6f;
constexpr float QSCALE = 0.14724445f;
constexpr int NCHUNK = SEQ / 64;

constexpr size_t MiB = 1u << 20;
constexpr size_t W_LSTRIDE = 26 * MiB;
constexpr size_t W_IN = 0, W_UQ = W_IN + (size_t)NPROJ * 1024 * 2, W_UKV = W_UQ + 768 * 768 * 2, W_OUT = W_UKV + 1024 * 256 * 2,
                 W_UP = W_OUT + 1024 * 1024 * 2, W_DN = W_UP + (size_t)4096 * 1024 * 2, W_END = W_DN + (size_t)4096 * 1024 * 2;
static_assert(W_END <= W_LSTRIDE, "weights");
constexpr size_t WS_COS = 56 * MiB, WS_SIN = 60 * MiB, WS_SSQH = 64 * MiB, WS_SSQQ = 65 * MiB, WS_SSQKV = 68 * MiB, WS_SSQO = 69 * MiB,
                 WS_DT = 73 * MiB, WS_KR = 75 * MiB, WS_CDEC = 79 * MiB;
constexpr size_t WS_HB = 96 * MiB;
constexpr size_t WS_STATES = 896 * MiB;
constexpr size_t WS_CQ = 224 * MiB, WS_CKV = 320 * MiB, WS_Z = 352 * MiB, WS_XBC = 416 * MiB, WS_Q = 544 * MiB, WS_KN = 640 * MiB, WS_VT = 704 * MiB;
constexpr size_t WS_HID = 224 * MiB;
constexpr size_t WS_MIX = 224 * MiB;
constexpr size_t WS_Y = 768 * MiB;
constexpr size_t WS_NEED = 1024 * MiB;

constexpr size_t WS_BAR = 80 * MiB;
constexpr int LDS_MISC = 131072 + 1024;
constexpr int LDS_BYTES = 147456;

__device__ __forceinline__ int tid_opaque() { int t = threadIdx.x; asm volatile("" : "+v"(t)); return t; }
__device__ __forceinline__ unsigned pk2(float lo, float hi) { f32x2_t v = {lo, hi}; bf16x2_t b = __builtin_convertvector(v, bf16x2_t); return __builtin_bit_cast(unsigned, b); }
__device__ __forceinline__ float bf2f(unsigned short b) { return __uint_as_float(((unsigned)b) << 16); }
__device__ __forceinline__ float bflo(unsigned w) { return __uint_as_float(w << 16); }
__device__ __forceinline__ float bfhi(unsigned w) { return __uint_as_float(w & 0xffff0000u); }
__device__ __forceinline__ float siluf(float v) { return v * __builtin_amdgcn_rcpf(1.f + __expf(-v)); }

struct WsPtrs {
    unsigned char* ws;
#define WSP_B(name, off) __device__ __forceinline__ bf16_t* name() const { return (bf16_t*)(ws + (off)); }
#define WSP_F(name, off) __device__ __forceinline__ float* name() const { return (float*)(ws + (off)); }
    WSP_B(CQ, WS_CQ) WSP_B(CKV, WS_CKV) WSP_B(Z, WS_Z) WSP_B(XBC, WS_XBC) WSP_B(KR, WS_KR) WSP_B(Q, WS_Q) WSP_B(KN, WS_KN) WSP_B(VT, WS_VT)
    WSP_B(Y, WS_Y) WSP_B(MIX, WS_MIX) WSP_B(HID, WS_HID) WSP_B(HB, WS_HB) WSP_B(STATES, WS_STATES)
    WSP_F(DT, WS_DT) WSP_F(SSQH, WS_SSQH) WSP_F(SSQQ, WS_SSQQ) WSP_F(SSQKV, WS_SSQKV) WSP_F(SSQO, WS_SSQO) WSP_F(COS, WS_COS) WSP_F(SIN, WS_SIN) WSP_F(CDEC, WS_CDEC)
};

namespace pg8 {
constexpr int BM = 256, BK = 64, HALF = 128, HTB = HALF * BK * 2, STAGE_BYTES = 8 * HTB, NXCD = 8, WGM = 8;
__host__ __device__ __forceinline__ int lds_byte(int r, int c) { const int st = (r >> 4) * 2 + (c >> 5), rr = r & 15, cc = c & 31, ob = rr * 64 + cc * 2; return st * 1024 + (ob ^ (((ob >> 9) & 1) << 5)); }
__host__ __device__ __forceinline__ void stage_rc(int b, int& R, int& C) { const int st = b / 1024, sb = b % 1024, swz = sb ^ (((sb >> 9) & 1) << 5); R = (st >> 1) * 16 + swz / 64; C = (st & 1) * 32 + (swz % 64) / 2; }
__host__ __device__ __forceinline__ int perm32(int rho) { const int n = rho >> 4, i = rho & 15; return 8 * (i >> 2) + 4 * n + (i & 3); }
struct Unit { int pm, pn; };
struct Gemm { const bf16_t* A; const bf16_t* Bt; int M, N, K; };
struct StaticOrder {
    int nM, nN, nwg, G, c;
    __host__ __device__ void init(int M, int N, int G_, int c_) { nM = M / BM; nN = N / BM; nwg = nM * nN; G = G_; c = c_; }
    __host__ __device__ bool next(int i, Unit& u) const {
        const long L = (long)i * G + c; if (L >= nwg) return false;
        int wgid = (int)L; { const int q = nwg / NXCD, r = nwg % NXCD, xcd = wgid % NXCD, off = wgid / NXCD; wgid = (xcd < r ? xcd * (q + 1) : r * (q + 1) + (xcd - r) * q) + off; }
        const int nig = WGM * nN, gid = wgid / nig, fm = gid * WGM, gsz = (nM - fm) < WGM ? (nM - fm) : WGM;
        u.pm = fm + ((wgid % nig) % gsz); u.pn = (wgid % nig) / gsz; return true;
    }
    __device__ __forceinline__ void a_ready(const Unit&) const {}
    __device__ __forceinline__ void done(const Unit&) const {}
};

template <class Epi, class Sched, bool ALIGN_EPI = false, bool SP2 = false>
__device__ __forceinline__ void gemm_phase(LAS unsigned char* lds, const Gemm g, const Sched& S, const Epi& E) {
    const int tid = tid_opaque(), wid = __builtin_amdgcn_readfirstlane(tid >> 6), lane = tid & 63, wr = wid >> 2, wc = wid & 3, fr = lane & 15, fq = lane >> 4;
    const int K = g.K, nt = K / BK;
    unsigned voffA[2], voffB[2];
#pragma unroll
    for (int i = 0; i < 2; ++i) { int R, C; stage_rc(tid * 16 + i * 8192, R, C); const int Rb = Epi::PERM ? ((R & ~31) + perm32(R & 31)) : R;
        voffA[i] = (unsigned)(R * K + C) * 2u; voffB[i] = (unsigned)(Rb * K + C) * 2u; }
    const size_t kstep = (size_t)(BK * 2);
    const size_t hstep = (size_t)HALF * K * 2;
    const size_t tstep = 2 * hstep;
    const unsigned ldsw = (unsigned)wid * 1024u;
    const int aoff = lds_byte(wr * 64 + fr, fq * 8), boff = lds_byte(wc * 32 + fr, fq * 8);
#define PG8_SA(b, h) (((b) * 2 + (h)) * HTB)
#define PG8_SB(b, h) ((4 + (b) * 2 + (h)) * HTB)
#define PG8_STAGE(bufoff, gbase, voff) do { _Pragma("unroll") for (int _i = 0; _i < 2; ++_i) \
        __builtin_amdgcn_global_load_lds((const unsigned*)((const char*)(gbase) + (voff)[_i]), (LAS unsigned*)(lds + (bufoff) + ldsw + _i * 8192), 16, 0, 0); } while (0)
#define PG8_LDA(dst, b, h) do { _Pragma("unroll") for (int m = 0; m < 4; ++m) _Pragma("unroll") for (int k = 0; k < 2; ++k) dst[m][k] = *(const LAS bf16x8*)(lds + PG8_SA(b, h) + aoff + m * 2048 + k * 1024); } while (0)
#define PG8_LDB(dst, b, h) do { _Pragma("unroll") for (int n = 0; n < 2; ++n) _Pragma("unroll") for (int k = 0; k < 2; ++k) dst[n][k] = *(const LAS bf16x8*)(lds + PG8_SB(b, h) + boff + n * 2048 + k * 1024); } while (0)
#define PG8_MMA(ai, bj, At, Bt) do { __builtin_amdgcn_s_setprio(1); _Pragma("unroll") for (int m = 0; m < 4; ++m) _Pragma("unroll") for (int n = 0; n < 2; ++n) _Pragma("unroll") for (int k = 0; k < 2; ++k) \
        acc[ai][bj][m][n] = __builtin_amdgcn_mfma_f32_16x16x32_bf16(Bt[n][k], At[m][k], acc[ai][bj][m][n], 0, 0, 0); __builtin_amdgcn_s_setprio(0); } while (0)
#define PG8_WAIT_V(n) asm volatile("s_waitcnt vmcnt(" #n ")" ::: "memory")
#define PG8_WAIT_L(n) asm volatile("s_waitcnt lgkmcnt(" #n ")" ::: "memory")
#define PG8_BAR __builtin_amdgcn_s_barrier()
#define PG8_SCHED __builtin_amdgcn_sched_barrier(0)
    Unit cur, nxt; int ui = 0;
    if (!S.next(0, cur)) return;
    f32x4 acc[2][2][4][2];
#pragma unroll
    for (int a = 0; a < 2; ++a)
#pragma unroll
        for (int b = 0; b < 2; ++b)
#pragma unroll
            for (int m = 0; m < 4; ++m)
#pragma unroll
                for (int n = 0; n < 2; ++n) acc[a][b][m][n] = (f32x4){0.f, 0.f, 0.f, 0.f};
    bf16x8 At[4][2], B0[2][2], B1[2][2];
    const char* cA = (const char*)g.A + (size_t)cur.pm * tstep; const char* cB = (const char*)g.Bt + (size_t)cur.pn * tstep;
    S.a_ready(cur);
    if constexpr (SP2) {
        PG8_STAGE(PG8_SB(0, 0), cB, voffB); PG8_STAGE(PG8_SB(0, 1), cB + hstep, voffB); PG8_STAGE(PG8_SA(0, 0), cA, voffA); PG8_STAGE(PG8_SA(0, 1), cA + hstep, voffA);
        if (wr == 1) PG8_BAR;
        PG8_WAIT_V(2); PG8_BAR;
        PG8_STAGE(PG8_SB(1, 0), cB + kstep, voffB); PG8_STAGE(PG8_SA(1, 0), cA + kstep, voffA); PG8_STAGE(PG8_SB(1, 1), cB + hstep + kstep, voffB);
        PG8_WAIT_V(6); PG8_BAR;
    } else {
        PG8_STAGE(PG8_SB(0, 0), cB, voffB); PG8_STAGE(PG8_SA(0, 0), cA, voffA); PG8_STAGE(PG8_SB(0, 1), cB + hstep, voffB); PG8_STAGE(PG8_SA(0, 1), cA + hstep, voffA);
        if (wr == 1) PG8_BAR;
        PG8_WAIT_V(4); PG8_BAR;
        PG8_STAGE(PG8_SB(1, 0), cB + kstep, voffB); PG8_STAGE(PG8_SA(1, 0), cA + kstep, voffA); PG8_STAGE(PG8_SB(1, 1), cB + hstep + kstep, voffB);
        PG8_WAIT_V(6); PG8_BAR;
    }
    for (;;) {
        const bool has_next = S.next(ui + 1, nxt);
        const char* nA = has_next ? (const char*)g.A + (size_t)nxt.pm * tstep : cA; const char* nB = has_next ? (const char*)g.Bt + (size_t)nxt.pn * tstep : cB;
        for (int t = 0; t < nt; t += 2) {
            const bool last = (t == nt - 2);
            const char* a1 = cA + (size_t)(t + 1) * kstep;
            const char* a2 = last ? nA : cA + (size_t)(t + 2) * kstep; const char* b2 = last ? nB : cB + (size_t)(t + 2) * kstep;
            const char* a3 = a2 + kstep; const char* b3 = b2 + kstep;
            if (last && has_next) S.a_ready(nxt);
            if constexpr (SP2) {
            PG8_LDB(B0, 0, 0); PG8_LDB(B1, 0, 1); PG8_SCHED; PG8_LDA(At, 0, 0); PG8_STAGE(PG8_SA(1, 1), a1 + hstep, voffA);
            PG8_WAIT_V(8); PG8_WAIT_L(0); PG8_BAR; PG8_MMA(0, 0, At, B0); PG8_MMA(0, 1, At, B1); PG8_BAR; PG8_SCHED;
            PG8_LDA(At, 0, 1); PG8_STAGE(PG8_SB(0, 0), b2, voffB); PG8_STAGE(PG8_SB(0, 1), b2 + hstep, voffB); PG8_STAGE(PG8_SA(0, 0), a2, voffA);
            PG8_WAIT_V(8); PG8_WAIT_L(0); PG8_BAR; PG8_MMA(1, 0, At, B0); PG8_MMA(1, 1, At, B1); PG8_BAR; PG8_SCHED;
            PG8_LDB(B0, 1, 0); PG8_LDB(B1, 1, 1); PG8_SCHED; PG8_LDA(At, 1, 0); PG8_STAGE(PG8_SA(0, 1), a2 + hstep, voffA);
            PG8_WAIT_V(8); PG8_WAIT_L(0); PG8_BAR; PG8_MMA(0, 0, At, B0); PG8_MMA(0, 1, At, B1); PG8_BAR; PG8_SCHED;
            PG8_LDA(At, 1, 1); PG8_STAGE(PG8_SB(1, 0), b3, voffB); PG8_STAGE(PG8_SB(1, 1), b3 + hstep, voffB); PG8_STAGE(PG8_SA(1, 0), a3, voffA);
            PG8_WAIT_V(8); PG8_WAIT_L(0); PG8_BAR; PG8_MMA(1, 0, At, B0); PG8_MMA(1, 1, At, B1); PG8_BAR; PG8_SCHED;
            } else {
            PG8_LDB(B0, 0, 0); PG8_SCHED; PG8_LDA(At, 0, 0); PG8_STAGE(PG8_SA(1, 1), a1 + hstep, voffA);
            PG8_WAIT_L(8); PG8_BAR; PG8_WAIT_L(0); PG8_MMA(0, 0, At, B0); PG8_BAR; PG8_SCHED;
            PG8_LDB(B1, 0, 1); PG8_STAGE(PG8_SB(0, 0), b2, voffB);
            PG8_BAR; PG8_WAIT_L(0); PG8_MMA(0, 1, At, B1); PG8_BAR;
            PG8_LDA(At, 0, 1); PG8_STAGE(PG8_SA(0, 0), a2, voffA);
            PG8_BAR; PG8_WAIT_L(0); PG8_MMA(1, 0, At, B0); PG8_BAR; PG8_SCHED;
            PG8_STAGE(PG8_SB(0, 1), b2 + hstep, voffB);
            PG8_WAIT_V(6); PG8_BAR; PG8_MMA(1, 1, At, B1); PG8_BAR;
            PG8_LDB(B0, 1, 0); PG8_SCHED; PG8_LDA(At, 1, 0); PG8_STAGE(PG8_SA(0, 1), a2 + hstep, voffA);
            PG8_WAIT_L(8); PG8_BAR; PG8_WAIT_L(0); PG8_MMA(0, 0, At, B0); PG8_BAR; PG8_SCHED;
            PG8_LDB(B1, 1, 1); PG8_STAGE(PG8_SB(1, 0), b3, voffB);
            PG8_BAR; PG8_WAIT_L(0); PG8_MMA(0, 1, At, B1); PG8_BAR;
            PG8_LDA(At, 1, 1); PG8_STAGE(PG8_SA(1, 0), a3, voffA);
            PG8_BAR; PG8_WAIT_L(0); PG8_MMA(1, 0, At, B0); PG8_BAR; PG8_SCHED;
            PG8_STAGE(PG8_SB(1, 1), b3 + hstep, voffB);
            PG8_WAIT_V(6); PG8_BAR; PG8_MMA(1, 1, At, B1); PG8_BAR;
            }
        }
        if constexpr (ALIGN_EPI) { if (wr == 0) PG8_BAR; }
        E(acc, cur, wr, wc, fr, fq); S.done(cur);
        if (!has_next) break;
#pragma unroll
        for (int a = 0; a < 2; ++a)
#pragma unroll
            for (int b = 0; b < 2; ++b)
#pragma unroll
                for (int m = 0; m < 4; ++m)
#pragma unroll
                    for (int n = 0; n < 2; ++n) acc[a][b][m][n] = (f32x4){0.f, 0.f, 0.f, 0.f};
        cur = nxt; cA = nA; cB = nB; ++ui;
        if constexpr (ALIGN_EPI) { if (wr == 1) PG8_BAR; }
    }
    PG8_WAIT_V(0);
    if constexpr (!ALIGN_EPI) { if (wr == 0) PG8_BAR; }
    PG8_BAR;
#undef PG8_SA
#undef PG8_SB
#undef PG8_STAGE
#undef PG8_LDA
#undef PG8_LDB
#undef PG8_MMA
#undef PG8_WAIT_V
#undef PG8_WAIT_L
#undef PG8_BAR
#undef PG8_SCHED
}
}

enum { M_INPROJ = 0, M_Q = 1, M_KV = 2, M_OUT = 3, M_UP = 4 };
__device__ __forceinline__ void st_bf4(bf16_t* p, f32x4 v) { u32x2 w; w.x = pk2(v[0], v[1]); w.y = pk2(v[2], v[3]); *(u32x2*)p = w; }
__device__ __forceinline__ float dot4(f32x4 v) { return (v[0] * v[0] + v[1] * v[1]) + (v[2] * v[2] + v[3] * v[3]); }
__device__ __forceinline__ float softplusf(float x) { return x > 20.f ? x : log1pf(__expf(x)); }

__device__ __forceinline__ void st_bf8(bf16_t* p, f32x4 a, f32x4 b) { u32x4 w; w.x = pk2(a[0], a[1]); w.y = pk2(a[2], a[3]); w.z = pk2(b[0], b[1]); w.w = pk2(b[2], b[3]); *(u32x4*)p = w; }
__device__ __forceinline__ f32x4 shfl32_4(f32x4 v) { f32x4 r; r[0] = __shfl_xor(v[0], 32); r[1] = __shfl_xor(v[1], 32); r[2] = __shfl_xor(v[2], 32); r[3] = __shfl_xor(v[3], 32); return r; }
__device__ __forceinline__ void rope_perm(f32x4& v0, f32x4& v1, const float* COS, const float* SIN, int row, int fq) {
    const f32x4 p0 = shfl32_4(v0), p1 = shfl32_4(v1);
    const int i0 = 8 * (fq & 1);
    const f32x4 c0 = *(const f32x4*)(COS + (size_t)row * 16 + i0), c1 = *(const f32x4*)(COS + (size_t)row * 16 + i0 + 4);
    const f32x4 s0 = *(const f32x4*)(SIN + (size_t)row * 16 + i0), s1 = *(const f32x4*)(SIN + (size_t)row * 16 + i0 + 4);
    if (fq < 2) { v0 = v0 * c0 - p0 * s0; v1 = v1 * c1 - p1 * s1; }
    else        { v0 = v0 * c0 + p0 * s0; v1 = v1 * c1 + p1 * s1; }
}

template <int MODE> struct Epi {
    static constexpr bool PERM = true, AFTER_DRAIN = false;
    WsPtrs P; const float* dtb; bf16_t* dst;
    __device__ __forceinline__ void operator()(const f32x4 (&acc)[2][2][4][2], const pg8::Unit& u, int wr, int wc, int fr, int fq) const {
        const int pn = u.pn;
        const int rowb = u.pm * 256 + wr * 64 + fr;
#pragma unroll
        for (int ai = 0; ai < 2; ++ai)
#pragma unroll
            for (int m = 0; m < 4; ++m) {
                const int row = rowb + ai * 128 + m * 16;
                if constexpr (MODE == M_INPROJ) {
                    const float rstd = rsqrtf(P.SSQH()[row] * (1.f / 1024.f) + EPS);
                    if (pn < 10) {
                        bf16_t* d; int ld, colt;
                        if (pn < 3) { d = P.CQ(); ld = 768; colt = pn * 256; } else if (pn == 3) { d = P.CKV(); ld = 256; colt = 0; }
                        else if (pn < 6) { d = P.Z(); ld = 512; colt = (pn - 4) * 256; } else { d = P.XBC(); ld = 1024; colt = (pn - 6) * 256; }
                        bf16_t* rp = d + (size_t)row * ld + colt + wc * 32 + 8 * fq;
                        float ss = 0.f;
#pragma unroll
                        for (int bj = 0; bj < 2; ++bj) { const f32x4 v0 = acc[ai][bj][m][0] * rstd, v1 = acc[ai][bj][m][1] * rstd; ss += dot4(v0) + dot4(v1); st_bf8(rp + bj * 128, v0, v1); }
                        if (pn < 4) { ss += __shfl_xor(ss, 16); ss += __shfl_xor(ss, 32);
                            if (fq == 0) { if (pn < 3) P.SSQQ()[(size_t)row * 12 + pn * 4 + wc] = ss; else P.SSQKV()[(size_t)row * 4 + wc] = ss; } }
                    } else {
                        if (wc == 0) {
                            f32x4 v0 = acc[ai][0][m][0] * rstd, v1 = acc[ai][0][m][1] * rstd;
                            rope_perm(v0, v1, P.COS(), P.SIN(), row, fq);
                            st_bf8(P.KR() + (size_t)row * 32 + 8 * fq, v0, v1);
                        } else if (wc == 1) {
                            if (fq == 0) { const f32x4 v0 = acc[ai][0][m][0] * rstd, v1 = acc[ai][0][m][1] * rstd; f32x4 o0, o1;
#pragma unroll
                                for (int j = 0; j < 4; ++j) { o0[j] = softplusf(v0[j] + dtb[j]); o1[j] = softplusf(v1[j] + dtb[4 + j]); }
                                *(f32x4*)(P.DT() + (size_t)row * 8) = o0; *(f32x4*)(P.DT() + (size_t)row * 8 + 4) = o1; }
                        }
                    }
                    asm volatile("" ::: "memory");
                } else if constexpr (MODE == M_Q) {
                    const f32x4 s0 = *(const f32x4*)(P.SSQQ() + (size_t)row * 12), s1 = *(const f32x4*)(P.SSQQ() + (size_t)row * 12 + 4), s2 = *(const f32x4*)(P.SSQQ() + (size_t)row * 12 + 8);
                    const float ssq = ((s0[0] + s0[1]) + (s0[2] + s0[3])) + ((s1[0] + s1[1]) + (s1[2] + s1[3])) + ((s2[0] + s2[1]) + (s2[2] + s2[3]));
                    const float rstd = rsqrtf(ssq * (1.f / 768.f) + EPS) * QSCALE;
#pragma unroll
                    for (int bj = 0; bj < 2; ++bj) {
                        const int gcol = pn * 256 + bj * 128 + wc * 32;
                        f32x4 v0 = acc[ai][bj][m][0] * rstd, v1 = acc[ai][bj][m][1] * rstd;
                        if ((gcol % 96) == 64) rope_perm(v0, v1, P.COS(), P.SIN(), row, fq);
                        st_bf8(P.Q() + (size_t)row * 768 + gcol + 8 * fq, v0, v1);
                    }
                } else if constexpr (MODE == M_KV) {
                    const f32x4 s0 = *(const f32x4*)(P.SSQKV() + (size_t)row * 4);
                    const float rstd = rsqrtf(((s0[0] + s0[1]) + (s0[2] + s0[3])) * (1.f / 256.f) + EPS);
                    if (wc < 2) {
                        char* kb_ = (char*)P.KN() + (size_t)(pn * 128) * 2;
                        const unsigned off = ((unsigned)row * 512u + (unsigned)(wc * 32 + 8 * fq)) * 2u;
#pragma unroll
                        for (int bj = 0; bj < 2; ++bj) st_bf8((bf16_t*)(kb_ + (off + (unsigned)(bj * 64) * 2u)), acc[ai][bj][m][0] * rstd, acc[ai][bj][m][1] * rstd);
                    } else {
                        const int b = (u.pm * 256) >> 13;
                        char* vb_ = (char*)P.VT() + ((size_t)((b * 8 + pn * 2) * 64 + (wc - 2) * 32)) * SEQ * 2;
                        const unsigned off = ((unsigned)(8 * fq) * (unsigned)SEQ + (unsigned)(row & (SEQ - 1))) * 2u;
#pragma unroll
                        for (int bj = 0; bj < 2; ++bj)
#pragma unroll
                            for (int n = 0; n < 2; ++n) { const f32x4 v = acc[ai][bj][m][n] * rstd;
#pragma unroll
                                for (int j = 0; j < 4; ++j)
                                    *(bf16_t*)(vb_ + (off + (unsigned)((bj * 64 + n * 4 + j) * SEQ) * 2u)) = (bf16_t)(pk2(v[j], 0.f) & 0xffffu); }
                    }
                    asm volatile("" ::: "memory");
                } else if constexpr (MODE == M_OUT) {
                    bf16_t* rp = dst + (size_t)row * 1024 + pn * 256 + wc * 32 + 8 * fq;
                    float ss = 0.f;
#pragma unroll
                    for (int bj = 0; bj < 2; ++bj) { const f32x4 v0 = acc[ai][bj][m][0], v1 = acc[ai][bj][m][1]; ss += dot4(v0) + dot4(v1); st_bf8(rp + bj * 128, v0, v1); }
                    ss += __shfl_xor(ss, 16); ss += __shfl_xor(ss, 32);
                    if (fq == 0) P.SSQO()[(size_t)row * 16 + pn * 4 + wc] = ss;
                } else {
                    const float rstd = rsqrtf(P.SSQH()[row] * (1.f / 1024.f) + EPS);
                    bf16_t* rp = P.HID() + (size_t)row * DFF + pn * 256 + wc * 32 + 8 * fq;
#pragma unroll
                    for (int bj = 0; bj < 2; ++bj) {
                        f32x4 v0 = acc[ai][bj][m][0] * rstd, v1 = acc[ai][bj][m][1] * rstd;
#pragma unroll
                        for (int j = 0; j < 4; ++j) { const float r0 = fmaxf(v0[j], 0.f), r1 = fmaxf(v1[j], 0.f); v0[j] = r0 * r0; v1[j] = r1 * r1; }
                        u32x4 w_; w_.x = pk2(v0[0], v0[1]); w_.y = pk2(v0[2], v0[3]); w_.z = pk2(v1[0], v1[1]); w_.w = pk2(v1[2], v1[3]);
                        __builtin_nontemporal_store(w_, (u32x4*)(rp + bj * 128));
                    }
                }
            }
    }
};

__device__ __forceinline__ float wave_sum(float v) {
#pragma unroll
    for (int o = 1; o < 64; o <<= 1) v += __shfl_xor(v, o);
    return v;
}
__device__ __forceinline__ void transpose_item(const float* W, int K, int N, bf16_t* WT, const float* nw, int mapmode, LAS float* scr, int item, int lane) {
    const int nblk = (N + 31) / 32, kb = item / nblk, nb = item % nblk, k0 = 64 * kb, n0 = 32 * nb;
#pragma unroll
    for (int i = 0; i < 8; ++i) { const int kk = 8 * i + (lane >> 3); const int n = n0 + 4 * (lane & 7);
        f32x4 v = (n < N) ? *(const f32x4*)(W + (size_t)(k0 + kk) * N + n) : (f32x4){0.f, 0.f, 0.f, 0.f}; if (nw) v = v * nw[k0 + kk];
        LAS float* d = scr + kk * 33 + 4 * (lane & 7); d[0] = v[0]; d[1] = v[1]; d[2] = v[2]; d[3] = v[3]; }
    asm volatile("s_waitcnt lgkmcnt(0)" ::: "memory");
    const int c = lane & 7;
#pragma unroll
    for (int j = 0; j < 4; ++j) { const int nl = (lane >> 3) + 8 * j; const int n = n0 + nl; const LAS float* s = scr + (8 * c) * 33 + nl;
        if (n < N) {
            int row = n;
            if (mapmode) { if (n >= 1024 && n < 1056) row = 2560 + (n - 1024); else if (n >= 1056 && n < 2592) row = n - 32; }
            u32x4 o; o.x = pk2(s[0 * 33], s[1 * 33]); o.y = pk2(s[2 * 33], s[3 * 33]); o.z = pk2(s[4 * 33], s[5 * 33]); o.w = pk2(s[6 * 33], s[7 * 33]);
            *(u32x4*)(WT + (size_t)row * K + k0 + 8 * c) = o; } }
    asm volatile("s_waitcnt lgkmcnt(0)" ::: "memory");
}

__constant__ float c_invf[16] = {1.0f, 0.5623413324356079f, 0.3162277638912201f, 0.17782793939113617f, 0.10000000149011612f, 0.05623413249850273f, 0.03162277489900589f, 0.017782794311642647f,
    0.009999999776482582f, 0.005623413249850273f, 0.003162277629598975f, 0.0017782794311642647f, 0.0010000000474974513f, 0.000562341301701963f, 0.0003162277571391314f, 0.00017782794020604342f};

struct Params { const float* in[20]; float* out; unsigned char* ws; int ph_lo, ph_hi; };
typedef const __attribute__((address_space(4))) Params* KP;
__device__ __forceinline__ KP kargs() { KP q = (KP)__builtin_amdgcn_kernarg_segment_ptr(); asm volatile("" : "+s"(q)); return q; }

__device__ __forceinline__ void phase_prep(KP pk, const WsPtrs& P, LAS unsigned char* lds, int vcu, int G) {
    const int tid = tid_opaque(), lane = tid & 63, wave = __builtin_amdgcn_readfirstlane(tid >> 6);
    LAS float* scr = (LAS float*)(lds + wave * 8448);
    const int gw = vcu * 8 + wave, NGW = G * 8;
    constexpr int I_IN = 16 * 82, I_UQ = 12 * 24, I_UKV = 4 * 32, I_OUT = 16 * 32, I_UP = 16 * 128, I_DN = 64 * 32, I_L = I_IN + I_UQ + I_UKV + I_OUT + I_UP + I_DN;
    for (int it = gw; it < NLAYER * I_L; it += NGW) {
        const int l = it / I_L; int r = it % I_L;
        unsigned char* wb = pk->ws + (size_t)l * W_LSTRIDE;
        if (r < I_IN) { transpose_item(pk->in[3] + (size_t)l * 1024 * NPROJ_SRC, 1024, NPROJ_SRC, (bf16_t*)(wb + W_IN), pk->in[2] + l * 1024, 1, scr, r, lane); continue; } r -= I_IN;
        if (r < I_UQ) { transpose_item(pk->in[5] + (size_t)l * 768 * 768, 768, 768, (bf16_t*)(wb + W_UQ), pk->in[4] + l * 768, 0, scr, r, lane); continue; } r -= I_UQ;
        if (r < I_UKV) { transpose_item(pk->in[7] + (size_t)l * 256 * 1024, 256, 1024, (bf16_t*)(wb + W_UKV), pk->in[6] + l * 256, 0, scr, r, lane); continue; } r -= I_UKV;
        if (r < I_OUT) { transpose_item(pk->in[14] + (size_t)l * 1024 * 1024, 1024, 1024, (bf16_t*)(wb + W_OUT), nullptr, 0, scr, r, lane); continue; } r -= I_OUT;
        if (r < I_UP) { transpose_item(pk->in[17] + (size_t)l * 1024 * 4096, 1024, 4096, (bf16_t*)(wb + W_UP), pk->in[16] + l * 1024, 0, scr, r, lane); continue; } r -= I_UP;
        transpose_item(pk->in[18] + (size_t)l * 4096 * 1024, 4096, 1024, (bf16_t*)(wb + W_DN), nullptr, 0, scr, r, lane);
    }
    { const int gt = vcu * 512 + tid, NT_ = G * 512; constexpr int NZ16 = 216 * 1024 * 2 / 16;
      for (int i = gt; i < NLAYER * NZ16; i += NT_) { const int l = i / NZ16, r = i % NZ16;
          *(u32x4*)(pk->ws + (size_t)l * W_LSTRIDE + W_IN + (size_t)2600 * 1024 * 2 + (size_t)r * 16) = (u32x4){0u, 0u, 0u, 0u}; } }
    { const int gt = vcu * 512 + tid, NT_ = G * 512; const int* pos = (const int*)pk->in[1];
      for (int i = gt; i < T * 16; i += NT_) { const int t = i >> 4, k = i & 15;
          const float ang = (float)pos[t] * c_invf[k];
          double rev = (double)ang * 0.15915494309189535; rev -= __builtin_rint(rev); const float fr = (float)rev;
          P.COS()[i] = __builtin_amdgcn_cosf(fr); P.SIN()[i] = __builtin_amdgcn_sinf(fr); } }
    for (int row = gw; row < T; row += NGW) {
        const f32x4* xr = (const f32x4*)(pk->in[0] + (size_t)row * DM) + lane; float ss = 0.f;
        u32x2* ob = (u32x2*)(P.HB() + (size_t)row * DM) + lane;
#pragma unroll
        for (int j = 0; j < 4; ++j) { const f32x4 v = __builtin_nontemporal_load(xr + 64 * j); ss += dot4(v); u32x2 w; w.x = pk2(v[0], v[1]); w.y = pk2(v[2], v[3]); ob[64 * j] = w; }
        ss = wave_sum(ss); if (lane == 0) P.SSQH()[row] = ss;
    }
}

template <bool IN_F32, bool OUT_F32>
__device__ __forceinline__ void phase_residual(const float* hin32, float* hout32, const bf16_t* mix, const float* nw, const WsPtrs& P, int vcu, int G) {
    const int tid = tid_opaque(), lane = tid & 63, wave = __builtin_amdgcn_readfirstlane(tid >> 6);
    const int gw = vcu * 8 + wave, NGW = G * 8;
    if constexpr (!IN_F32 && !OUT_F32) {
        f32x4 wa[2], wb[2];
#pragma unroll
        for (int j = 0; j < 2; ++j) { wa[j] = *(const f32x4*)(nw + 8 * lane + 512 * j); wb[j] = *(const f32x4*)(nw + 8 * lane + 512 * j + 4); }
        for (int row0 = gw; row0 < T; row0 += 2 * NGW) {
            float sq[2]; u32x4 hw[2][2], mw[2][2];
#pragma unroll
            for (int k = 0; k < 2; ++k) { const int row = row0 + k * NGW;
                sq[k] = P.SSQO()[(size_t)row * 16 + (lane & 15)];
#pragma unroll
                for (int j = 0; j < 2; ++j) { hw[k][j] = *((const u32x4*)(P.HB() + (size_t)row * DM) + lane + 64 * j); mw[k][j] = __builtin_nontemporal_load((const u32x4*)(mix + (size_t)row * DM) + lane + 64 * j); } }
#pragma unroll
            for (int k = 0; k < 2; ++k) { const int row = row0 + k * NGW;
                float s_ = sq[k]; s_ += __shfl_xor(s_, 1); s_ += __shfl_xor(s_, 2); s_ += __shfl_xor(s_, 4); s_ += __shfl_xor(s_, 8);
                const float rstd = rsqrtf(s_ * (1.f / 1024.f) + EPS);
                float ss = 0.f;
#pragma unroll
                for (int j = 0; j < 2; ++j) {
                    const f32x4 xa = {bflo(hw[k][j].x), bfhi(hw[k][j].x), bflo(hw[k][j].y), bfhi(hw[k][j].y)}, xb = {bflo(hw[k][j].z), bfhi(hw[k][j].z), bflo(hw[k][j].w), bfhi(hw[k][j].w)};
                    const f32x4 ma = {bflo(mw[k][j].x), bfhi(mw[k][j].x), bflo(mw[k][j].y), bfhi(mw[k][j].y)}, mb = {bflo(mw[k][j].z), bfhi(mw[k][j].z), bflo(mw[k][j].w), bfhi(mw[k][j].w)};
                    const f32x4 ha = xa + ma * rstd * wa[j], hb_ = xb + mb * rstd * wb[j];
                    ss += dot4(ha) + dot4(hb_);
                    u32x4 o; o.x = pk2(ha[0], ha[1]); o.y = pk2(ha[2], ha[3]); o.z = pk2(hb_[0], hb_[1]); o.w = pk2(hb_[2], hb_[3]);
                    *((u32x4*)(P.HB() + (size_t)row * DM) + lane + 64 * j) = o;
                }
                ss = wave_sum(ss); if (lane == 0) P.SSQH()[row] = ss; }
        }
        return;
    }
    f32x4 w4[4];
#pragma unroll
    for (int j = 0; j < 4; ++j) w4[j] = *((const f32x4*)nw + lane + 64 * j);
    for (int row0 = gw; row0 < T; row0 += 2 * NGW) {
        float sq[2]; u32x2 hw[2][4], mw[2][4]; f32x4 xf[2][4];
#pragma unroll
        for (int k = 0; k < 2; ++k) { const int row = row0 + k * NGW;
            sq[k] = P.SSQO()[(size_t)row * 16 + (lane & 15)];
#pragma unroll
            for (int j = 0; j < 4; ++j) {
                if (IN_F32) xf[k][j] = __builtin_nontemporal_load((const f32x4*)(hin32 + (size_t)row * DM) + lane + 64 * j);
                else hw[k][j] = ((const u32x2*)(P.HB() + (size_t)row * DM) + lane)[64 * j];
                mw[k][j] = __builtin_nontemporal_load((const u32x2*)(mix + (size_t)row * DM) + lane + 64 * j); } }
#pragma unroll
        for (int k = 0; k < 2; ++k) { const int row = row0 + k * NGW;
            float s_ = sq[k]; s_ += __shfl_xor(s_, 1); s_ += __shfl_xor(s_, 2); s_ += __shfl_xor(s_, 4); s_ += __shfl_xor(s_, 8);
            const float rstd = rsqrtf(s_ * (1.f / 1024.f) + EPS);
            u32x2* hb = (u32x2*)(P.HB() + (size_t)row * DM) + lane;
            float ss = 0.f;
#pragma unroll
            for (int j = 0; j < 4; ++j) {
                f32x4 x;
                if (IN_F32) x = xf[k][j]; else x = (f32x4){bflo(hw[k][j].x), bfhi(hw[k][j].x), bflo(hw[k][j].y), bfhi(hw[k][j].y)};
                const f32x4 mv = {bflo(mw[k][j].x), bfhi(mw[k][j].x), bflo(mw[k][j].y), bfhi(mw[k][j].y)};
                const f32x4 hn = x + mv * rstd * w4[j];
                if (OUT_F32) __builtin_nontemporal_store(hn, (f32x4*)(hout32 + (size_t)row * DM) + lane + 64 * j);
                else { ss += dot4(hn); u32x2 w; w.x = pk2(hn[0], hn[1]); w.y = pk2(hn[2], hn[3]); hb[64 * j] = w; }
            }
            if (!OUT_F32) { ss = wave_sum(ss); if (lane == 0) P.SSQH()[row] = ss; } }
    }
}

constexpr int KPITCH = 208, VPITCH = 144, ATT_KBUF = 64 * KPITCH, ATT_VBUF = 64 * VPITCH, ATT_BUF = ATT_KBUF + ATT_VBUF;
#define MFMA32(a, b, c) __builtin_amdgcn_mfma_f32_32x32x16_bf16(a, b, c, 0, 0, 0)
#define MFMA16(a, b, c) __builtin_amdgcn_mfma_f32_16x16x32_bf16(a, b, c, 0, 0, 0)

__device__ __forceinline__ float max3f(float a, float b, float c) { float r; asm("v_max3_f32 %0, %1, %2, %3" : "=v"(r) : "v"(a), "v"(b), "v"(c)); return r; }
__device__ __forceinline__ float max2f(float a, float b) { float r; asm("v_max_f32_e32 %0, %1, %2" : "=v"(r) : "v"(a), "v"(b)); return r; }
constexpr float ATT_THR = 8.f;
__device__ __forceinline__ void attn_unit(LAS unsigned char* lds, const WsPtrs& P, int b, int h, int qb) {
    const int tid = tid_opaque(), lane = tid & 63, w = __builtin_amdgcn_readfirstlane(tid >> 6), r32 = lane & 31, hi = lane >> 5;
    const int q0 = qb * 256, ntw = 4 * qb + (w >> 1) + 1, NT = 4 * qb + 4;
    const size_t tokb = (size_t)b * SEQ;
    bf16x8 qf[6];
    { const bf16_t* qp = P.Q() + (tokb + q0 + 32 * w + r32) * 768 + h * 96 + 8 * hi;
#pragma unroll
      for (int s = 0; s < 6; ++s) qf[s] = *(const bf16x8*)(qp + 16 * s); }
    const int kr = tid >> 3, kc = tid & 7, rr = (tid >> 2) & 63, rc = tid & 3;
    const char* kbase = (const char*)(P.KN() + tokb * 512 + h * 64);
    const char* rbase = (const char*)(P.KR() + tokb * 32);
    const char* vbase = (const char*)(P.VT() + ((size_t)((b * 8 + h) * 64)) * SEQ);
    const unsigned koff = (unsigned)(kr * 512 + kc * 8) * 2u, roff = (unsigned)(rr * 32 + rc * 8) * 2u, voff = (unsigned)(kr * SEQ + kc * 8) * 2u;
    const int kdst = kr * KPITCH + kc * 16, rdst = rr * KPITCH + 128 + rc * 16, vdst = ATT_KBUF + kr * VPITCH + (kc >> 1) * 32 + (kc & 1) * 8;
    const int kfo = r32 * KPITCH + hi * 16, vfo = ATT_KBUF + r32 * VPITCH + hi * 16;
    u32x4 kregX, rregX = {0u, 0u, 0u, 0u}, vregX, kregY, rregY = {0u, 0u, 0u, 0u}, vregY;
#define ATT_GLOAD(S, t) do { kreg##S = *(const u32x4*)(kbase + (size_t)(t) * (64 * 512 * 2) + koff); rreg##S = *(const u32x4*)(rbase + (size_t)(t) * (64 * 32 * 2) + roff); vreg##S = *(const u32x4*)(vbase + (size_t)(t) * (64 * 2) + voff); } while (0)
#define ATT_LSTORE(S, boff) do { LAS unsigned char* bb = lds + (boff); *(LAS u32x4*)(bb + kdst) = kreg##S; if (w < 4) *(LAS u32x4*)(bb + rdst) = rreg##S;   \
        *(LAS u32x2*)(bb + vdst) = (u32x2){vreg##S.x, vreg##S.y}; *(LAS u32x2*)(bb + vdst + 16) = (u32x2){vreg##S.z, vreg##S.w}; } while (0)
#define ATT_BAR() do { asm volatile("s_waitcnt lgkmcnt(0)" ::: "memory"); __builtin_amdgcn_s_barrier(); asm volatile("" ::: "memory"); } while (0)
#define ATT_QK(P0, P1, boff) do { const LAS unsigned char* kb_ = lds + (boff) + kfo; \
        { const bf16x8 k0 = *(const LAS bf16x8*)(kb_); const bf16x8 k1 = *(const LAS bf16x8*)(kb_ + 32 * KPITCH); P0 = MFMA32(k0, qf[0], negm); P1 = MFMA32(k1, qf[0], negm); } \
        _Pragma("unroll") for (int s_ = 1; s_ < 6; ++s_) { const bf16x8 k0 = *(const LAS bf16x8*)(kb_ + s_ * 32); const bf16x8 k1 = *(const LAS bf16x8*)(kb_ + 32 * KPITCH + s_ * 32); \
            P0 = MFMA32(k0, qf[s_], P0); P1 = MFMA32(k1, qf[s_], P1); } } while (0)
#define ATT_SM1(P0, P1, MREF) do { \
        float rm = max2f(P0[0], P1[0]), rm2_ = max2f(P0[1], P1[1]); \
        _Pragma("unroll") for (int r_ = 2; r_ < 16; r_ += 2) { rm = max3f(rm, P0[r_], P1[r_]); rm2_ = max3f(rm2_, P0[r_ + 1], P1[r_ + 1]); } \
        rm = max2f(rm, rm2_); \
        { auto sw_ = __builtin_amdgcn_permlane32_swap(__float_as_uint(rm), __float_as_uint(rm), false, false); rm = max2f(__uint_as_float(sw_[0]), __uint_as_float(sw_[1])); } \
        const bool need_ = ((MREF) + rm > mrun + ATT_THR) || ((MREF) != mrun); \
        if (__builtin_amdgcn_ballot_w64(need_) != 0ull) { \
            const float mn_ = fmaxf(mrun, (MREF) + rm), alpha_ = __builtin_amdgcn_exp2f(mrun - mn_), sub_ = mn_ - (MREF); \
            lrun *= alpha_; \
            _Pragma("unroll") for (int r_ = 0; r_ < 16; ++r_) { ot0[r_] *= alpha_; ot1[r_] *= alpha_; P0[r_] -= sub_; P1[r_] -= sub_; } \
            mrun = mn_; mcin = mn_; \
            _Pragma("unroll") for (int r_ = 0; r_ < 16; ++r_) negm[r_] = -mn_; \
            asm volatile("" : "+v"(negm)); } } while (0)
#define ATT_SM2(P0, P1) do { \
        f32x2_t sa_ = {0.f, 0.f}, sb_ = {0.f, 0.f}; \
        _Pragma("unroll") for (int r_ = 0; r_ < 16; r_ += 2) { P0[r_] = __builtin_amdgcn_exp2f(P0[r_]); P0[r_ + 1] = __builtin_amdgcn_exp2f(P0[r_ + 1]); P1[r_] = __builtin_amdgcn_exp2f(P1[r_]); P1[r_ + 1] = __builtin_amdgcn_exp2f(P1[r_ + 1]); \
            sa_ += (f32x2_t){P0[r_], P0[r_ + 1]}; sb_ += (f32x2_t){P1[r_], P1[r_ + 1]}; } \
        sa_ += sb_; lrun += sa_.x + sa_.y; } while (0)
#define ATT_PV(P0, P1, boff) do { \
        u32x4 pw_[4]; \
        _Pragma("unroll") for (int j_ = 0; j_ < 4; ++j_) { pw_[0][j_] = pk2(P0[2 * j_], P0[2 * j_ + 1]); pw_[1][j_] = pk2(P0[8 + 2 * j_], P0[9 + 2 * j_]); pw_[2][j_] = pk2(P1[2 * j_], P1[2 * j_ + 1]); pw_[3][j_] = pk2(P1[8 + 2 * j_], P1[9 + 2 * j_]); } \
        const LAS unsigned char* vb_ = lds + (boff) + vfo; \
        _Pragma("unroll") for (int ks_ = 0; ks_ < 4; ++ks_) { \
            const bf16x8 pa_ = __builtin_bit_cast(bf16x8, pw_[ks_]); \
            const bf16x8 vf0 = *(const LAS bf16x8*)(vb_ + ks_ * 32); \
            const bf16x8 vf1 = *(const LAS bf16x8*)(vb_ + 32 * VPITCH + ks_ * 32); \
            ot0 = MFMA32(vf0, pa_, ot0); ot1 = MFMA32(vf1, pa_, ot1); } } while (0)
#define ATT_ROT() do { const int t_ = bc; bc = bn; bn = bnn; bnn = b3; b3 = t_; } while (0)
    if (w < 4) __builtin_amdgcn_s_setprio(1);
    float mrun = -1e30f, lrun = 0.f, mcin = 0.f, mrefA = 0.f, mrefB = 0.f;
    f32x16 ot0 = {}, ot1 = {}, negm = {};
    asm volatile("" : "+v"(negm));
    f32x16 pA0, pA1, pB0, pB1;
    { u32x4 kregZ, rregZ, vregZ;
      ATT_GLOAD(X, 0); ATT_GLOAD(Y, 1); ATT_GLOAD(Z, 2); ATT_LSTORE(X, 0); ATT_LSTORE(Y, ATT_BUF); ATT_LSTORE(Z, 2 * ATT_BUF); }
    ATT_GLOAD(Y, 3); ATT_BAR();
    ATT_QK(pA0, pA1, 0); mrefA = mcin;
    asm volatile("s_nop 15\n\ts_nop 15" : "+v"(pA0), "+v"(pA1));
    if (w >= 4) ATT_BAR();
#define ATT_STEP(PN0, PN1, MREFN, PC0, PC1, MREFC, tt, LS, SS, BC, BN, B3) do {   \
        { const int tl_ = (tt) + 4 < NT ? (tt) + 4 : NT - 1; ATT_GLOAD(LS, tl_); }   \
        if ((tt) < ntw) { ATT_SM1(PC0, PC1, MREFC); __builtin_amdgcn_sched_barrier(0); ATT_QK(PN0, PN1, (BN) * ATT_BUF); MREFN = mcin; ATT_SM2(PC0, PC1); }   \
        ATT_BAR(); \
        if ((tt) < ntw) { ATT_PV(PC0, PC1, (BC) * ATT_BUF); } \
        ATT_LSTORE(SS, (B3) * ATT_BUF); \
        ATT_BAR(); } while (0)
    for (int t = 0; t < NT; t += 4) {
        ATT_STEP(pB0, pB1, mrefB, pA0, pA1, mrefA, t, X, Y, 0, 1, 3);
        ATT_STEP(pA0, pA1, mrefA, pB0, pB1, mrefB, t + 1, Y, X, 1, 2, 0);
        ATT_STEP(pB0, pB1, mrefB, pA0, pA1, mrefA, t + 2, X, Y, 2, 3, 1);
        ATT_STEP(pA0, pA1, mrefA, pB0, pB1, mrefB, t + 3, Y, X, 3, 0, 2);
    }
    if (w < 4) ATT_BAR();
#undef ATT_STEP
    __builtin_amdgcn_s_setprio(0);
    lrun += __shfl_xor(lrun, 32);
    const float inv = 1.f / lrun;
    bf16_t* yp = P.Y() + (tokb + q0 + 32 * w + r32) * 1024 + h * 64 + 4 * hi;
#pragma unroll
    for (int g = 0; g < 4; ++g) {
        st_bf4(yp + 8 * g, (f32x4){ot0[4 * g] * inv, ot0[4 * g + 1] * inv, ot0[4 * g + 2] * inv, ot0[4 * g + 3] * inv});
        st_bf4(yp + 32 + 8 * g, (f32x4){ot1[4 * g] * inv, ot1[4 * g + 1] * inv, ot1[4 * g + 2] * inv, ot1[4 * g + 3] * inv});
    }
#undef ATT_GLOAD
#undef ATT_LSTORE
#undef ATT_QK
#undef ATT_SM1
#undef ATT_SM2
#undef ATT_PV
#undef ATT_ROT
#undef ATT_BAR
}

constexpr int SL_ACS = 0, SL_DTL = 1024, SL_SSQ = 2048, SL_XT = 4096  , XR_PITCH = 544, SL_B = SL_XT + 36864  , BC_PITCH = 272, B1_PITCH = 288  ,
              SL_C = SL_B + 18432  , SL_S = SL_C + 64 * BC_PITCH  , S_PITCH = 144, S_HEAD = 64 * S_PITCH, SL_END = SL_S + 4 * S_HEAD;
static_assert(SL_END <= 131072 && 64 * XR_PITCH <= 36864 && 64 * B1_PITCH <= 18432, "ssd lds");
typedef short v4i16_t __attribute__((ext_vector_type(4)));
__device__ __forceinline__ bf16x8 tr_frag(const LAS unsigned char* img, int pitch, int k0, int colbyte0, int lane) {
    const int g = lane >> 4, q = (lane & 15) >> 2, p = lane & 3;
    const LAS unsigned char* a = img + (k0 + 8 * g + q) * pitch + colbyte0 + p * 8;
    const v4i16_t lo = __builtin_amdgcn_ds_read_tr16_b64_v4i16((LAS v4i16_t*)a), hi = __builtin_amdgcn_ds_read_tr16_b64_v4i16((LAS v4i16_t*)(a + 4 * pitch));
    return (bf16x8){lo[0], lo[1], lo[2], lo[3], hi[0], hi[1], hi[2], hi[3]};
}

__device__ __forceinline__ void ssd_scan_dt(LAS unsigned char* lds, const WsPtrs& P, const float* a_log, size_t t0, int g, int bc, bool write_cdec) {
    const int tid = tid_opaque(), lane = tid & 63, w = __builtin_amdgcn_readfirstlane(tid >> 6);
    if (w < 4) {
        const int head = 4 * g + w;
        const float dtv = P.DT()[(t0 + lane) * 8 + head];
        float a = -dtv * __expf(a_log[head]);
#pragma unroll
        for (int off = 1; off < 64; off <<= 1) { const float t = __shfl_up(a, off); if (lane >= off) a += t; }
        ((LAS float*)(lds + SL_ACS))[w * 64 + lane] = a; ((LAS float*)(lds + SL_DTL))[w * 64 + lane] = dtv;
        if (write_cdec && lane == 63) P.CDEC()[(size_t)bc * 8 + head] = __expf(a);
    }
}

#define SSD_BAR() do { asm volatile("s_waitcnt lgkmcnt(0)" ::: "memory"); __builtin_amdgcn_s_barrier(); asm volatile("" ::: "memory"); } while (0)
struct ConvIn { float wk[4][8]; float bs[8]; u32x4 raw[11]; };
__device__ __forceinline__ void ssd_conv_load(ConvIn& ci, const WsPtrs& P, const float* cw, const float* cb, size_t t0, int c, int g, int tid) {
    const int cg_ = tid & 63, rb = tid >> 6;
    const int col = cg_ < 32 ? g * 256 + cg_ * 8 : (cg_ < 48 ? 512 + g * 128 + (cg_ - 32) * 8 : 768 + g * 128 + (cg_ - 48) * 8);
    const bf16_t* src = P.XBC() + t0 * 1024 + col;
#pragma unroll
    for (int i = 0; i < 11; ++i) { const int lr = 8 * rb - 3 + i;
        if (lr < 0 && c == 0) ci.raw[i] = (u32x4){0u, 0u, 0u, 0u}; else ci.raw[i] = *(const u32x4*)(src + (ptrdiff_t)lr * 1024); }
#pragma unroll
    for (int k = 0; k < 4; ++k) { const f32x4 a = *(const f32x4*)(cw + k * 1024 + col), b2 = *(const f32x4*)(cw + k * 1024 + col + 4);
#pragma unroll
        for (int e = 0; e < 4; ++e) { ci.wk[k][e] = a[e]; ci.wk[k][4 + e] = b2[e]; } }
    { const f32x4 a = *(const f32x4*)(cb + col), b2 = *(const f32x4*)(cb + col + 4);
#pragma unroll
      for (int e = 0; e < 4; ++e) { ci.bs[e] = a[e]; ci.bs[4 + e] = b2[e]; } }
}
template <int MODE>
__device__ __forceinline__ void ssd_conv_compute(const ConvIn& ci, LAS unsigned char* lds, int tid) {
    const int cg_ = tid & 63, rb = tid >> 6;
    if (MODE == 1 && cg_ >= 48) return;
    const LAS float* ACS = (const LAS float*)(lds + SL_ACS); const LAS float* DTL = (const LAS float*)(lds + SL_DTL);
    const int hh = cg_ >> 3;
    LAS unsigned char* base; int pitch;
    if (cg_ < 32) { base = lds + SL_XT + cg_ * 16; pitch = XR_PITCH; }
    else if (cg_ < 48) { base = lds + SL_B + (cg_ - 32) * 16; pitch = (MODE == 1) ? B1_PITCH : BC_PITCH; }
    else { base = lds + SL_C + (cg_ - 48) * 16; pitch = BC_PITCH; }
#pragma unroll
    for (int r = 0; r < 8; ++r) {
        const int s0 = 8 * rb + r;
        float o[8];
#pragma unroll
        for (int e2 = 0; e2 < 4; ++e2) {
            f32x2_t a2 = {ci.bs[2 * e2], ci.bs[2 * e2 + 1]};
#pragma unroll
            for (int k = 0; k < 4; ++k) { const unsigned wd = ci.raw[r + k][e2]; const f32x2_t x2 = {bflo(wd), bfhi(wd)}; const f32x2_t w2 = {ci.wk[k][2 * e2], ci.wk[k][2 * e2 + 1]}; a2 = x2 * w2 + a2; }
            const f32x2_t n2 = a2 * (-1.4426950408889634f);
            f32x2_t d2; d2.x = __builtin_amdgcn_exp2f(n2.x); d2.y = __builtin_amdgcn_exp2f(n2.y); d2 = d2 + 1.0f;
            f32x2_t r2; r2.x = __builtin_amdgcn_rcpf(d2.x); r2.y = __builtin_amdgcn_rcpf(d2.y);
            const f32x2_t o2 = a2 * r2; o[2 * e2] = o2.x; o[2 * e2 + 1] = o2.y;
        }
        float wgt = 1.f;
        if (MODE == 1 && cg_ < 32) wgt = DTL[hh * 64 + s0] * __expf(ACS[hh * 64 + 63] - ACS[hh * 64 + s0]);
        *(LAS u32x4*)(base + s0 * pitch) = (u32x4){pk2(o[0] * wgt, o[1] * wgt), pk2(o[2] * wgt, o[3] * wgt), pk2(o[4] * wgt, o[5] * wgt), pk2(o[6] * wgt, o[7] * wgt)};
    }
}

__device__ __forceinline__ void ssd_s1_unit(LAS unsigned char* lds, const WsPtrs& P, const float* cw, const float* cb, const float* a_log, int u) {
    const int g = u & 1, c = (u >> 1) & 127, b = u >> 8;
    const int tid = tid_opaque(), lane = tid & 63, w = __builtin_amdgcn_readfirstlane(tid >> 6), r = lane & 15, q4 = lane >> 4;
    const size_t t0 = (size_t)b * SEQ + c * 64;
    ConvIn ci; ssd_conv_load(ci, P, cw, cb, t0, c, g, tid);
    ssd_scan_dt(lds, P, a_log, t0, g, b * NCHUNK + c, true);
    __syncthreads();
    ssd_conv_compute<1>(ci, lds, tid);
    __syncthreads();
    const int hh = w >> 1;
    bf16_t* sb = P.STATES() + ((size_t)((b * NCHUNK + c) * 8 + 4 * g + hh)) * 64 * 128;
#pragma unroll
    for (int pt2 = 0; pt2 < 2; ++pt2) {
        const int pt = 2 * (w & 1) + pt2;
        bf16x8 xb[2];
#pragma unroll
        for (int ks = 0; ks < 2; ++ks) xb[ks] = tr_frag(lds + SL_XT, XR_PITCH, 32 * ks, (hh * 64 + 16 * pt) * 2, lane);
#pragma unroll
        for (int nt = 0; nt < 8; ++nt) {
            f32x4 acc = {0.f, 0.f, 0.f, 0.f};
#pragma unroll
            for (int ks = 0; ks < 2; ++ks) { const bf16x8 bt = tr_frag(lds + SL_B, B1_PITCH, 32 * ks, (16 * nt) * 2, lane); acc = MFMA16(bt, xb[ks], acc); }
            st_bf4(sb + (size_t)(16 * pt + r) * 128 + 16 * nt + 4 * q4, acc);
        }
    }
    SSD_BAR();
}

__device__ __forceinline__ void ssd_s2(const WsPtrs& P, int vcu, int G) {
    const int tid = tid_opaque();
    if (tid >= 256) return;
    for (int e = vcu * 256 + tid; e < BATCH * 8 * 64 * 16; e += G * 256) {
        const int n8 = e & 15, pp = (e >> 4) & 63, h = (e >> 10) & 7, b = e >> 13;
        bf16_t* base = P.STATES() + ((size_t)(b * NCHUNK) * 8 + h) * 8192 + pp * 128 + n8 * 8;
        const float* dec = P.CDEC() + (size_t)(b * NCHUNK) * 8 + h;
        float hs[8];
#pragma unroll
        for (int k = 0; k < 8; ++k) hs[k] = 0.f;
        for (int c0 = 0; c0 < NCHUNK; c0 += 8) {
            u32x4 st[8]; float d[8];
#pragma unroll
            for (int i = 0; i < 8; ++i) { st[i] = *(const u32x4*)(base + (size_t)(c0 + i) * 65536); d[i] = dec[(c0 + i) * 8]; }
            asm volatile("" ::: "memory");
#pragma unroll
            for (int i = 0; i < 8; ++i) {
                u32x4 o; o.x = pk2(hs[0], hs[1]); o.y = pk2(hs[2], hs[3]); o.z = pk2(hs[4], hs[5]); o.w = pk2(hs[6], hs[7]);
                *(u32x4*)(base + (size_t)(c0 + i) * 65536) = o;
                hs[0] = hs[0] * d[i] + bflo(st[i].x); hs[1] = hs[1] * d[i] + bfhi(st[i].x); hs[2] = hs[2] * d[i] + bflo(st[i].y); hs[3] = hs[3] * d[i] + bfhi(st[i].y);
                hs[4] = hs[4] * d[i] + bflo(st[i].z); hs[5] = hs[5] * d[i] + bfhi(st[i].z); hs[6] = hs[6] * d[i] + bflo(st[i].w); hs[7] = hs[7] * d[i] + bfhi(st[i].w);
            }
            asm volatile("" ::: "memory");
        }
    }
}

__device__ __forceinline__ void ssd_s3_unit(LAS unsigned char* lds, const WsPtrs& P, const float* cw, const float* cb, const float* a_log, const float* dskip, const float* nrm, int u) {
    const int g = u & 1, c = (u >> 1) & 127, b = u >> 8;
    const int tid = tid_opaque(), lane = tid & 63, w = __builtin_amdgcn_readfirstlane(tid >> 6), r = lane & 15, q4 = lane >> 4;
    const size_t t0 = (size_t)b * SEQ + c * 64;
    ConvIn ci; ssd_conv_load(ci, P, cw, cb, t0, c, g, tid);
    u32x2 zw[2][4];
    { const int hh_ = w >> 1;
#pragma unroll
      for (int a = 0; a < 2; ++a)
#pragma unroll
          for (int pt = 0; pt < 4; ++pt) zw[a][pt] = *(const u32x2*)(P.Z() + (t0 + 16 * (2 * (w & 1) + a) + r) * 512 + (4 * g + hh_) * 64 + 16 * pt + 4 * q4); }
    ssd_scan_dt(lds, P, a_log, t0, g, 0, false);
    __syncthreads();
    ssd_conv_compute<3>(ci, lds, tid);
    bf16x8 pvf[4][4];
    { const bf16_t* pb = P.STATES() + ((size_t)((b * NCHUNK + c) * 8 + 4 * g + (w >> 1))) * 8192;
#pragma unroll
      for (int ks = 0; ks < 4; ++ks)
#pragma unroll
          for (int pt = 0; pt < 4; ++pt) pvf[ks][pt] = *(const bf16x8*)(pb + (size_t)(16 * pt + r) * 128 + ks * 32 + q4 * 8); }
    __syncthreads();
    const LAS float* ACS = (const LAS float*)(lds + SL_ACS); const LAS float* DTL = (const LAS float*)(lds + SL_DTL);
    {
        const int lt = w >> 1;
#pragma unroll
        for (int s2 = 0; s2 < 2; ++s2) {
            const int st = 2 * (w & 1) + s2;
            f32x4 gacc = {0.f, 0.f, 0.f, 0.f};
            if (st <= lt) {
#pragma unroll
                for (int ks = 0; ks < 4; ++ks) {
                    const bf16x8 ca = *(const LAS bf16x8*)(lds + SL_C + (16 * lt + r) * BC_PITCH + ks * 64 + q4 * 16);
                    const bf16x8 bb = *(const LAS bf16x8*)(lds + SL_B + (16 * st + r) * BC_PITCH + ks * 64 + q4 * 16);
                    gacc = MFMA16(bb, ca, gacc);
                }
            }
            const int l = 16 * lt + r, sb = 16 * st + 4 * q4;
#pragma unroll
            for (int hh = 0; hh < 4; ++hh) {
                const float al = ACS[hh * 64 + l];
                const f32x4 as = *(const LAS f32x4*)(ACS + hh * 64 + sb), ds = *(const LAS f32x4*)(DTL + hh * 64 + sb);
                f32x4 v;
#pragma unroll
                for (int i = 0; i < 4; ++i) v[i] = (l >= sb + i) ? gacc[i] * __expf(al - as[i]) * ds[i] : 0.f;
                *(LAS u32x2*)(lds + SL_S + hh * S_HEAD + l * S_PITCH + sb * 2) = (u32x2){pk2(v[0], v[1]), pk2(v[2], v[3])};
            }
        }
    }
    __syncthreads();
    const int hh = w >> 1, head = 4 * g + hh;
    f32x4 acc[2][4];
#pragma unroll
    for (int a = 0; a < 2; ++a)
#pragma unroll
        for (int pt = 0; pt < 4; ++pt) acc[a][pt] = (f32x4){0.f, 0.f, 0.f, 0.f};
    {
#pragma unroll
        for (int ks = 0; ks < 4; ++ks) {
            bf16x8 ca[2];
#pragma unroll
            for (int a = 0; a < 2; ++a) ca[a] = *(const LAS bf16x8*)(lds + SL_C + (16 * (2 * (w & 1) + a) + r) * BC_PITCH + ks * 64 + q4 * 16);
#pragma unroll
            for (int pt = 0; pt < 4; ++pt) {
                const bf16x8 pv = pvf[ks][pt];
#pragma unroll
                for (int a = 0; a < 2; ++a) acc[a][pt] = MFMA16(pv, ca[a], acc[a][pt]);
            }
        }
#pragma unroll
        for (int a = 0; a < 2; ++a) {
            const float sc = __expf(ACS[hh * 64 + 16 * (2 * (w & 1) + a) + r]);
#pragma unroll
            for (int pt = 0; pt < 4; ++pt) acc[a][pt] *= sc;
        }
    }
#pragma unroll
    for (int ks = 0; ks < 2; ++ks) {
        bf16x8 sa[2];
#pragma unroll
        for (int a = 0; a < 2; ++a) sa[a] = *(const LAS bf16x8*)(lds + SL_S + hh * S_HEAD + (16 * (2 * (w & 1) + a) + r) * S_PITCH + ks * 64 + q4 * 16);
#pragma unroll
        for (int pt = 0; pt < 4; ++pt) {
            const bf16x8 xb = tr_frag(lds + SL_XT, XR_PITCH, 32 * ks, (hh * 64 + 16 * pt) * 2, lane);
#pragma unroll
            for (int a = 0; a < 2; ++a) acc[a][pt] = MFMA16(xb, sa[a], acc[a][pt]);
        }
    }
    const float dsk = dskip[head];
#pragma unroll
    for (int a = 0; a < 2; ++a) {
        const int l = 16 * (2 * (w & 1) + a) + r;
        float ssq = 0.f;
#pragma unroll
        for (int pt = 0; pt < 4; ++pt) {
            const int p0 = 16 * pt + 4 * q4;
            const float zv[4] = {bflo(zw[a][pt].x), bfhi(zw[a][pt].x), bflo(zw[a][pt].y), bfhi(zw[a][pt].y)};
            const u32x2 xw = *(const LAS u32x2*)(lds + SL_XT + l * XR_PITCH + (hh * 64 + p0) * 2);
            const float xq[4] = {bflo(xw.x), bfhi(xw.x), bflo(xw.y), bfhi(xw.y)};
#pragma unroll
            for (int i = 0; i < 4; ++i) {
                const float xv = xq[i];
                const float y = (acc[a][pt][i] + dsk * xv) * siluf(zv[i]);
                acc[a][pt][i] = y; ssq += y * y;
            }
        }
        ssq += __shfl_xor(ssq, 16); ssq += __shfl_xor(ssq, 32);
        if (q4 == 0) ((LAS float*)(lds + SL_SSQ))[hh * 64 + l] = ssq;
    }
    __syncthreads();
    {
        const LAS float* SQ = (const LAS float*)(lds + SL_SSQ);
#pragma unroll
        for (int a = 0; a < 2; ++a) {
            const int l = 16 * (2 * (w & 1) + a) + r;
            const float rstd = rsqrtf(((SQ[l] + SQ[64 + l]) + (SQ[128 + l] + SQ[192 + l])) * (1.f / 256.f) + EPS);
#pragma unroll
            for (int pt = 0; pt < 4; ++pt) {
                const int ch = head * 64 + 16 * pt + 4 * q4;
                const f32x4 nw = *(const f32x4*)(nrm + ch);
                st_bf4(P.Y() + (t0 + l) * 1024 + 512 + ch, acc[a][pt] * rstd * nw);
            }
        }
    }
    SSD_BAR();
}

#define XB_TMO      128
#define XB_XCNT(j)  (256  + 64 * (j))
#define XB_XSUB(j)  (1280 + 64 * (j))
#define XB_XGEN(j)  (2304 + 64 * (j))
#define XB_TOP      3328
#define XB_TOPGEN   3392
#define XCD_BAR_WORDS 3456
#define XB_SPIN_CAP (1u << 21)
__device__ __forceinline__ unsigned xb_ld(unsigned* p)              { return __hip_atomic_load(p, __ATOMIC_RELAXED, __HIP_MEMORY_SCOPE_AGENT); }
__device__ __forceinline__ unsigned xb_add(unsigned* p, unsigned v) { return __hip_atomic_fetch_add(p, v, __ATOMIC_RELAXED, __HIP_MEMORY_SCOPE_AGENT); }
__device__ __forceinline__ unsigned xb_xcc_id() { return (unsigned)__builtin_amdgcn_s_getreg((3 << 11) | 20) & 0xFu; }
#define XB_SPIN(cond, bar) do { unsigned _sp = 0; while (cond) { __builtin_amdgcn_s_sleep(1); \
    if ((++_sp & 255u) == 0u) { if (xb_ld(&(bar)[XB_TMO])) break; if (_sp > XB_SPIN_CAP) { atomicAdd(&(bar)[XB_TMO], 1u); break; } } } } while (0)
struct XcdBarrier { unsigned* bar; unsigned x; volatile LAS unsigned* st; };
__device__ __forceinline__ XcdBarrier xcd_barrier_post(unsigned* bar, volatile LAS unsigned* st) {
    XcdBarrier b; b.bar = bar; b.x = xb_xcc_id(); b.st = st;
    if (threadIdx.x == 0) (void)xb_add(&bar[XB_XCNT(b.x)], 1u);
    return b;
}
__device__ __forceinline__ void xcd_barrier_complete(unsigned* bar, unsigned x, unsigned& nloc, unsigned& nx) {
    const unsigned G = gridDim.x * gridDim.y * gridDim.z;
    unsigned sum, cnt, mine, sp = 0u;
    for (;;) {
        sum = 0u; cnt = 0u; mine = 0u;
#pragma unroll
        for (unsigned j = 0; j < 16; ++j) { const unsigned c = xb_ld(&bar[XB_XCNT(j)]); sum += c; cnt += (c > 0u) ? 1u : 0u; mine = (j == x) ? c : mine; }
        if (sum == G) break;
        __builtin_amdgcn_s_sleep(1);
        if ((++sp & 255u) == 0u) { if (xb_ld(&bar[XB_TMO])) break; if (sp > XB_SPIN_CAP) { atomicAdd(&bar[XB_TMO], 1u); break; } }
    }
    nloc = mine > 0u ? mine : 1u; nx = cnt > 0u ? cnt : 1u;
}
__device__ __forceinline__ void xcd_barrier(const XcdBarrier& b) {
    asm volatile("s_waitcnt vmcnt(0)" ::: "memory");
    __syncthreads();
    if (threadIdx.x == 0) {
        unsigned* bar = b.bar;
        __builtin_amdgcn_s_waitcnt(0);
        unsigned nloc = b.st[0], nx = b.st[1];
        if (nloc == 0u) { xcd_barrier_complete(bar, b.x, nloc, nx); b.st[0] = nloc; b.st[1] = nx; }
        const unsigned old = xb_add(&bar[XB_XSUB(b.x)], 1u);
        const unsigned gen = old / nloc;
        if (old + 1u == (gen + 1u) * nloc) {
            __builtin_amdgcn_fence(__ATOMIC_RELEASE, "agent");
            asm volatile("s_waitcnt vmcnt(0)" ::: "memory");
            const unsigned og = xb_add(&bar[XB_TOP], 1u);
            const unsigned tg = og / nx;
            if (og + 1u == (tg + 1u) * nx) xb_add(&bar[XB_TOPGEN], 1u);
            else XB_SPIN(xb_ld(&bar[XB_TOPGEN]) == tg, bar);
            __builtin_amdgcn_fence(__ATOMIC_ACQUIRE, "agent");
            xb_add(&bar[XB_XGEN(b.x)], 1u);
            asm volatile("s_waitcnt vmcnt(0)" ::: "memory");
        } else {
            XB_SPIN(xb_ld(&bar[XB_XGEN(b.x)]) == gen, bar);
            __builtin_amdgcn_fence(__ATOMIC_ACQUIRE, "agent");
            asm volatile("s_waitcnt vmcnt(0)" ::: "memory");
        }
    }
    __syncthreads();
}

constexpr int PH_PER_LAYER = 9, N_PHASES = 1 + NLAYER * PH_PER_LAYER;

#define PH_BEGIN(k) if (ph_lo <= (k) && (k) < ph_hi) { KP pk = kargs(); WsPtrs P; P.ws = pk->ws; int G = gridDim.x, bx = blockIdx.x; asm volatile("" : "+s"(G), "+s"(bx)); \
        const int vcu = (G % 8 == 0) ? (bx % 8) * (G / 8) + bx / 8 : bx; (void)vcu; (void)bx;
#define PH_END(k) if ((k) + 1 < ph_hi) { if ((k) == 0) cg::this_grid().sync(); else xcd_barrier(xb); } }

__device__ __forceinline__ void run_layer(const int l, const int pb, const int ph_lo, const int ph_hi, LAS unsigned char* lds, const XcdBarrier& xb) {
    PH_BEGIN(pb + 0) {
        unsigned char* wb = P.ws + (size_t)l * W_LSTRIDE;
        pg8::Gemm g{P.HB(), (const bf16_t*)(wb + W_IN), T, NPROJ, 1024}; pg8::StaticOrder S; S.init(T, NPROJ, G, bx);
        Epi<M_INPROJ> E{P, pk->in[10] + l * 8, nullptr};
        pg8::gemm_phase<Epi<M_INPROJ>, pg8::StaticOrder, true, true>(lds, g, S, E);
    } PH_END(pb + 0)
    PH_BEGIN(pb + 1) {
        unsigned char* wb = P.ws + (size_t)l * W_LSTRIDE;
        pg8::Gemm g{P.CQ(), (const bf16_t*)(wb + W_UQ), T, 768, 768}; pg8::StaticOrder S; S.init(T, 768, G, bx);
        Epi<M_Q> E{P, nullptr, nullptr}; pg8::gemm_phase<Epi<M_Q>, pg8::StaticOrder, true, true>(lds, g, S, E);
    } }
    PH_BEGIN(pb + 1) {
        unsigned char* wb = P.ws + (size_t)l * W_LSTRIDE;
        pg8::Gemm g{P.CKV(), (const bf16_t*)(wb + W_UKV), T, 1024, 256}; pg8::StaticOrder S; S.init(T, 1024, G, bx);
        Epi<M_KV> E{P, nullptr, nullptr}; pg8::gemm_phase<Epi<M_KV>, pg8::StaticOrder, true, true>(lds, g, S, E);
    } }
    PH_BEGIN(pb + 1) {
        for (int u = vcu; u < BATCH * NCHUNK * 2; u += G) ssd_s1_unit(lds, P, pk->in[8] + l * 4096, pk->in[9] + l * 1024, pk->in[11] + l * 8, u);
    } PH_END(pb + 1)
    PH_BEGIN(pb + 2) {
        ssd_s2(P, vcu, G);
    } }
    PH_BEGIN(pb + 2) {
        for (int u = vcu; u < 2048; u += G) { const int i = u >> 8, vv = u & 255, bh = vv >> 2, s = vv & 3, j = i >> 1;
            const int qb = (i & 1) ? 8 * j + 7 - s : 8 * j + s;
            attn_unit(lds, P, bh >> 3, bh & 7, qb); }
    } PH_END(pb + 2)
    PH_BEGIN(pb + 3) {
        for (int u = vcu; u < BATCH * NCHUNK * 2; u += G) ssd_s3_unit(lds, P, pk->in[8] + l * 4096, pk->in[9] + l * 1024, pk->in[11] + l * 8, pk->in[12] + l * 8, pk->in[13] + l * 512, u);
    } PH_END(pb + 3)
    PH_BEGIN(pb + 4) {
        unsigned char* wb = P.ws + (size_t)l * W_LSTRIDE;
        pg8::Gemm g{P.Y(), (const bf16_t*)(wb + W_OUT), T, 1024, 1024}; pg8::StaticOrder S; S.init(T, 1024, G, bx);
        Epi<M_OUT> E{P, nullptr, P.MIX()}; pg8::gemm_phase<Epi<M_OUT>, pg8::StaticOrder, true, true>(lds, g, S, E);
    } PH_END(pb + 4)
    PH_BEGIN(pb + 5) {
        if (l == 0) phase_residual<true, false>(pk->in[0], nullptr, P.MIX(), pk->in[15] + l * 1024, P, vcu, G);
        else phase_residual<false, false>(nullptr, nullptr, P.MIX(), pk->in[15] + l * 1024, P, vcu, G);
    } PH_END(pb + 5)
    PH_BEGIN(pb + 6) {
        unsigned char* wb = P.ws + (size_t)l * W_LSTRIDE;
        pg8::Gemm g{P.HB(), (const bf16_t*)(wb + W_UP), T, DFF, 1024}; pg8::StaticOrder S; S.init(T, DFF, G, bx);
        Epi<M_UP> E{P, nullptr, nullptr}; pg8::gemm_phase<Epi<M_UP>, pg8::StaticOrder, true, true>(lds, g, S, E);
    } PH_END(pb + 6)
    PH_BEGIN(pb + 7) {
        unsigned char* wb = P.ws + (size_t)l * W_LSTRIDE;
        pg8::Gemm g{P.HID(), (const bf16_t*)(wb + W_DN), T, 1024, DFF}; pg8::StaticOrder S; S.init(T, 1024, G, bx);
        Epi<M_OUT> E{P, nullptr, P.Y()}; pg8::gemm_phase<Epi<M_OUT>, pg8::StaticOrder, true, true>(lds, g, S, E);
    } PH_END(pb + 7)
    PH_BEGIN(pb + 8) {
        if (l == NLAYER - 1) phase_residual<false, true>(nullptr, pk->out, P.Y(), pk->in[19] + l * 1024, P, vcu, G);
        else phase_residual<false, false>(nullptr, nullptr, P.Y(), pk->in[19] + l * 1024, P, vcu, G);
    } PH_END(pb + 8)
}

__global__ void __launch_bounds__(512) fwd_kernel(Params p) {
    extern __shared__ __attribute__((aligned(16))) unsigned char lds_raw[];
    LAS unsigned char* lds = (LAS unsigned char*)lds_raw;
    const int ph_lo = p.ph_lo, ph_hi = p.ph_hi;
    { volatile LAS unsigned* misc = (volatile LAS unsigned*)(lds + LDS_MISC); if (threadIdx.x < 8) misc[threadIdx.x] = 0u; }
    __syncthreads();
    XcdBarrier xb; { KP pk0 = kargs(); xb = xcd_barrier_post((unsigned*)(pk0->ws + WS_BAR), (volatile LAS unsigned*)(lds + LDS_MISC)); }
    PH_BEGIN(0) {
        phase_prep(pk, P, lds, vcu, G);
    } PH_END(0)
    run_layer(0, 1, ph_lo, ph_hi, lds, xb);
    run_layer(1, 1 + PH_PER_LAYER, ph_lo, ph_hi, lds, xb);
}

extern "C" void kernel_launch(void* const* d_in, const int* in_sizes, int n_in, void* d_out, int out_size, void* d_ws, size_t ws_size, hipStream_t stream) {
    static int grid = 0;
    if (grid == 0) {
        if (n_in != 20 || out_size != T * DM || ws_size < WS_NEED) { fprintf(stderr, "kernel_launch: unexpected problem (n_in %d out %d ws %zu)\n", n_in, out_size, ws_size); grid = -1; return; }
        int dev = 0, cus = 0, per_cu = 0;
        hipGetDevice(&dev); hipDeviceGetAttribute(&cus, hipDeviceAttributeMultiprocessorCount, dev);
        if (hipFuncSetAttribute((const void*)fwd_kernel, hipFuncAttributeMaxDynamicSharedMemorySize, LDS_BYTES) != hipSuccess) { fprintf(stderr, "kernel_launch: hipFuncSetAttribute failed\n"); grid = -1; return; }
        if (hipOccupancyMaxActiveBlocksPerMultiprocessor(&per_cu, (const void*)fwd_kernel, 512, LDS_BYTES) != hipSuccess || per_cu < 1) { fprintf(stderr, "kernel_launch: occupancy query says %d\n", per_cu); per_cu = 1; }
        (void)hipGetLastError();
        grid = cus;
    }
    if (grid < 0) return;
    (void)hipMemsetAsync((char*)d_ws + WS_BAR, 0, 16384, stream);
    Params a{};
    for (int i = 0; i < 20; ++i) a.in[i] = (const float*)d_in[i];
    a.out = (float*)d_out; a.ws = (unsigned char*)d_ws;
#if MK_COOP
    a.ph_lo = 0; a.ph_hi = N_PHASES;
    void* args[] = {&a};
    hipError_t e = hipLaunchCooperativeKernel((const void*)fwd_kernel, dim3(grid), dim3(512), args, LDS_BYTES, stream);
    if (e != hipSuccess) fprintf(stderr, "cooperative launch failed: %s (grid %d)\n", hipGetErrorString(e), grid);
#else
    for (int ph = 0; ph < N_PHASES; ++ph) {
        a.ph_lo = ph; a.ph_hi = ph + 1;
        hipLaunchKernelGGL(fwd_kernel, dim3(grid), dim3(512), LDS_BYTES, stream, a);
    }
#endif
}
```

```cpp
#include <hip/hip_runtime.h>
#include <hip/hip_cooperative_groups.h>
#include <cstdio>
#include <cstdint>
namespace cg = cooperative_groups;

#ifndef MK_COOP
#define MK_COOP 1
#endif

#ifndef PH_MASK
#define PH_MASK 0x1fff
#endif
#define LAS __attribute__((address_space(3)))
typedef unsigned short bf16_t;
typedef short bf16x8 __attribute__((ext_vector_type(8)));
typedef short s16x4 __attribute__((ext_vector_type(4)));
typedef float f32x4 __attribute__((ext_vector_type(4)));
typedef float f32x16 __attribute__((ext_vector_type(16)));
typedef unsigned u32x4 __attribute__((ext_vector_type(4)));
typedef unsigned u32x2 __attribute__((ext_vector_type(2)));
typedef float f32x2_t __attribute__((ext_vector_type(2)));
typedef __bf16 bf16x2_t __attribute__((ext_vector_type(2)));

constexpr int BATCH = 8, SEQ = 8192, DM = 1024, T = BATCH * SEQ;
constexpr int NQL = 768, NKVL = 256, NPROJ_SRC = 2600, NPROJ = 2816, DFF = 4096;
constexpr int NLAYER = 2;
constexpr float EPS = 1e-6f;
constexpr float QSCALE = 0.14724445f;
constexpr int NCHUNK = SEQ / 64;

constexpr size_t MiB = 1u << 20;
constexpr size_t W_LSTRIDE = 26 * MiB;
constexpr size_t W_IN = 0, W_UQ = W_IN + (size_t)NPROJ * 1024 * 2, W_UKV = W_UQ + 768 * 768 * 2, W_OUT = W_UKV + 1024 * 256 * 2,
                 W_UP = W_OUT + 1024 * 1024 * 2, W_DN = W_UP + (size_t)4096 * 1024 * 2, W_END = W_DN + (size_t)4096 * 1024 * 2;
static_assert(W_END <= W_LSTRIDE, "weights");
constexpr size_t WS_COS = 56 * MiB, WS_SIN = 60 * MiB, WS_SSQH = 64 * MiB, WS_SSQQ = 65 * MiB, WS_SSQKV = 68 * MiB, WS_SSQO = 69 * MiB,
                 WS_DT = 73 * MiB, WS_KR = 75 * MiB, WS_CDEC = 79 * MiB;
constexpr size_t WS_HB = 96 * MiB;
constexpr size_t WS_STATES = 896 * MiB;
constexpr size_t WS_CQ = 224 * MiB, WS_CKV = 320 * MiB, WS_Z = 352 * MiB, WS_XBC = 416 * MiB, WS_Q = 544 * MiB, WS_KN = 640 * MiB, WS_VT = 704 * MiB;
constexpr size_t WS_HID = 224 * MiB;
constexpr size_t WS_MIX = 224 * MiB;
constexpr size_t WS_Y = 768 * MiB;
constexpr size_t WS_NEED = 1024 * MiB;

constexpr size_t WS_BAR = 80 * MiB;
constexpr int LDS_MISC = 131072 + 1024;
constexpr int LDS_BYTES = 147456;

__device__ __forceinline__ int tid_opaque() { int t = threadIdx.x; asm volatile("" : "+v"(t)); return t; }
__device__ __forceinline__ unsigned pk2(float lo, float hi) { f32x2_t v = {lo, hi}; bf16x2_t b = __builtin_convertvector(v, bf16x2_t); return __builtin_bit_cast(unsigned, b); }
__device__ __forceinline__ float bf2f(unsigned short b) { return __uint_as_float(((unsigned)b) << 16); }
__device__ __forceinline__ float bflo(unsigned w) { return __uint_as_float(w << 16); }
__device__ __forceinline__ float bfhi(unsigned w) { return __uint_as_float(w & 0xffff0000u); }
__device__ __forceinline__ float siluf(float v) { return v * __builtin_amdgcn_rcpf(1.f + __expf(-v)); }

struct WsPtrs {
    unsigned char* ws;
#define WSP_B(name, off) __device__ __forceinline__ bf16_t* name() const { return (bf16_t*)(ws + (off)); }
#define WSP_F(name, off) __device__ __forceinline__ float* name() const { return (float*)(ws + (off)); }
    WSP_B(CQ, WS_CQ) WSP_B(CKV, WS_CKV) WSP_B(Z, WS_Z) WSP_B(XBC, WS_XBC) WSP_B(KR, WS_KR) WSP_B(Q, WS_Q) WSP_B(KN, WS_KN) WSP_B(VT, WS_VT)
    WSP_B(Y, WS_Y) WSP_B(MIX, WS_MIX) WSP_B(HID, WS_HID) WSP_B(HB, WS_HB) WSP_B(STATES, WS_STATES)
    WSP_F(DT, WS_DT) WSP_F(SSQH, WS_SSQH) WSP_F(SSQQ, WS_SSQQ) WSP_F(SSQKV, WS_SSQKV) WSP_F(SSQO, WS_SSQO) WSP_F(COS, WS_COS) WSP_F(SIN, WS_SIN) WSP_F(CDEC, WS_CDEC)
};

namespace pg8 {
constexpr int BM = 256, BK = 64, HALF = 128, HTB = HALF * BK * 2, STAGE_BYTES = 8 * HTB, NXCD = 8, WGM = 8;
__host__ __device__ __forceinline__ int lds_byte(int r, int c) { const int st = (r >> 4) * 2 + (c >> 5), rr = r & 15, cc = c & 31, ob = rr * 64 + cc * 2; return st * 1024 + (ob ^ (((ob >> 9) & 1) << 5)); }
__host__ __device__ __forceinline__ void stage_rc(int b, int& R, int& C) { const int st = b / 1024, sb = b % 1024, swz = sb ^ (((sb >> 9) & 1) << 5); R = (st >> 1) * 16 + swz / 64; C = (st & 1) * 32 + (swz % 64) / 2; }
__host__ __device__ __forceinline__ int perm32(int rho) { const int n = rho >> 4, i = rho & 15; return 8 * (i >> 2) + 4 * n + (i & 3); }
struct Unit { int pm, pn; };
struct Gemm { const bf16_t* A; const bf16_t* Bt; int M, N, K; };
struct StaticOrder {
    int nM, nN, nwg, G, c;
    __host__ __device__ void init(int M, int N, int G_, int c_) { nM = M / BM; nN = N / BM; nwg = nM * nN; G = G_; c = c_; }
    __host__ __device__ bool next(int i, Unit& u) const {
        const long L = (long)i * G + c; if (L >= nwg) return false;
        int wgid = (int)L; { const int q = nwg / NXCD, r = nwg % NXCD, xcd = wgid % NXCD, off = wgid / NXCD; wgid = (xcd < r ? xcd * (q + 1) : r * (q + 1) + (xcd - r) * q) + off; }
        const int nig = WGM * nN, gid = wgid / nig, fm = gid * WGM, gsz = (nM - fm) < WGM ? (nM - fm) : WGM;
        u.pm = fm + ((wgid % nig) % gsz); u.pn = (wgid % nig) / gsz; return true;
    }
    __device__ __forceinline__ void a_ready(const Unit&) const {}
    __device__ __forceinline__ void done(const Unit&) const {}
};

template <class Epi, class Sched, bool ALIGN_EPI = false, bool SP2 = false>
__device__ __forceinline__ void gemm_phase(LAS unsigned char* lds, const Gemm g, const Sched& S, const Epi& E) {
    const int tid = tid_opaque(), wid = __builtin_amdgcn_readfirstlane(tid >> 6), lane = tid & 63, wr = wid >> 2, wc = wid & 3, fr = lane & 15, fq = lane >> 4;
    const int K = g.K, nt = K / BK;
    unsigned voffA[2], voffB[2];
#pragma unroll
    for (int i = 0; i < 2; ++i) { int R, C; stage_rc(tid * 16 + i * 8192, R, C); const int Rb = Epi::PERM ? ((R & ~31) + perm32(R & 31)) : R;
        voffA[i] = (unsigned)(R * K + C) * 2u; voffB[i] = (unsigned)(Rb * K + C) * 2u; }
    const size_t kstep = (size_t)(BK * 2);
    const size_t hstep = (size_t)HALF * K * 2;
    const size_t tstep = 2 * hstep;
    const unsigned ldsw = (unsigned)wid * 1024u;
    const int aoff = lds_byte(wr * 64 + fr, fq * 8), boff = lds_byte(wc * 32 + fr, fq * 8);
#define PG8_SA(b, h) (((b) * 2 + (h)) * HTB)
#define PG8_SB(b, h) ((4 + (b) * 2 + (h)) * HTB)
#define PG8_STAGE(bufoff, gbase, voff) do { _Pragma("unroll") for (int _i = 0; _i < 2; ++_i) \
        __builtin_amdgcn_global_load_lds((const unsigned*)((const char*)(gbase) + (voff)[_i]), (LAS unsigned*)(lds + (bufoff) + ldsw + _i * 8192), 16, 0, 0); } while (0)
#define PG8_LDA(dst, b, h) do { _Pragma("unroll") for (int m = 0; m < 4; ++m) _Pragma("unroll") for (int k = 0; k < 2; ++k) dst[m][k] = *(const LAS bf16x8*)(lds + PG8_SA(b, h) + aoff + m * 2048 + k * 1024); } while (0)
#define PG8_LDB(dst, b, h) do { _Pragma("unroll") for (int n = 0; n < 2; ++n) _Pragma("unroll") for (int k = 0; k < 2; ++k) dst[n][k] = *(const LAS bf16x8*)(lds + PG8_SB(b, h) + boff + n * 2048 + k * 1024); } while (0)
#define PG8_MMA(ai, bj, At, Bt) do { __builtin_amdgcn_s_setprio(1); _Pragma("unroll") for (int m = 0; m < 4; ++m) _Pragma("unroll") for (int n = 0; n < 2; ++n) _Pragma("unroll") for (int k = 0; k < 2; ++k) \
        acc[ai][bj][m][n] = __builtin_amdgcn_mfma_f32_16x16x32_bf16(Bt[n][k], At[m][k], acc[ai][bj][m][n], 0, 0, 0); __builtin_amdgcn_s_setprio(0); } while (0)
#define PG8_WAIT_V(n) asm volatile("s_waitcnt vmcnt(" #n ")" ::: "memory")
#define PG8_WAIT_L(n) asm volatile("s_waitcnt lgkmcnt(" #n ")" ::: "memory")
#define PG8_BAR __builtin_amdgcn_s_barrier()
#define PG8_SCHED __builtin_amdgcn_sched_barrier(0)
    Unit cur, nxt; int ui = 0;
    if (!S.next(0, cur)) return;
    f32x4 acc[2][2][4][2];
#pragma unroll
    for (int a = 0; a < 2; ++a)
#pragma unroll
        for (int b = 0; b < 2; ++b)
#pragma unroll
            for (int m = 0; m < 4; ++m)
#pragma unroll
                for (int n = 0; n < 2; ++n) acc[a][b][m][n] = (f32x4){0.f, 0.f, 0.f, 0.f};
    bf16x8 At[4][2], B0[2][2], B1[2][2];
    const char* cA = (const char*)g.A + (size_t)cur.pm * tstep; const char* cB = (const char*)g.Bt + (size_t)cur.pn * tstep;
    S.a_ready(cur);
    if constexpr (SP2) {
        PG8_STAGE(PG8_SB(0, 0), cB, voffB); PG8_STAGE(PG8_SB(0, 1), cB + hstep, voffB); PG8_STAGE(PG8_SA(0, 0), cA, voffA); PG8_STAGE(PG8_SA(0, 1), cA + hstep, voffA);
        if (wr == 1) PG8_BAR;
        PG8_WAIT_V(2); PG8_BAR;
        PG8_STAGE(PG8_SB(1, 0), cB + kstep, voffB); PG8_STAGE(PG8_SA(1, 0), cA + kstep, voffA); PG8_STAGE(PG8_SB(1, 1), cB + hstep + kstep, voffB);
        PG8_WAIT_V(6); PG8_BAR;
    } else {
        PG8_STAGE(PG8_SB(0, 0), cB, voffB); PG8_STAGE(PG8_SA(0, 0), cA, voffA); PG8_STAGE(PG8_SB(0, 1), cB + hstep, voffB); PG8_STAGE(PG8_SA(0, 1), cA + hstep, voffA);
        if (wr == 1) PG8_BAR;
        PG8_WAIT_V(4); PG8_BAR;
        PG8_STAGE(PG8_SB(1, 0), cB + kstep, voffB); PG8_STAGE(PG8_SA(1, 0), cA + kstep, voffA); PG8_STAGE(PG8_SB(1, 1), cB + hstep + kstep, voffB);
        PG8_WAIT_V(6); PG8_BAR;
    }
    for (;;) {
        const bool has_next = S.next(ui + 1, nxt);
        const char* nA = has_next ? (const char*)g.A + (size_t)nxt.pm * tstep : cA; const char* nB = has_next ? (const char*)g.Bt + (size_t)nxt.pn * tstep : cB;
        for (int t = 0; t < nt; t += 2) {
            const bool last = (t == nt - 2);
            const char* a1 = cA + (size_t)(t + 1) * kstep;
            const char* a2 = last ? nA : cA + (size_t)(t + 2) * kstep; const char* b2 = last ? nB : cB + (size_t)(t + 2) * kstep;
            const char* a3 = a2 + kstep; const char* b3 = b2 + kstep;
            if (last && has_next) S.a_ready(nxt);
            if constexpr (SP2) {
            PG8_LDB(B0, 0, 0); PG8_LDB(B1, 0, 1); PG8_SCHED; PG8_LDA(At, 0, 0); PG8_STAGE(PG8_SA(1, 1), a1 + hstep, voffA);
            PG8_WAIT_V(8); PG8_WAIT_L(0); PG8_BAR; PG8_MMA(0, 0, At, B0); PG8_MMA(0, 1, At, B1); PG8_BAR; PG8_SCHED;
            PG8_LDA(At, 0, 1); PG8_STAGE(PG8_SB(0, 0), b2, voffB); PG8_STAGE(PG8_SB(0, 1), b2 + hstep, voffB); PG8_STAGE(PG8_SA(0, 0), a2, voffA);
            PG8_WAIT_V(8); PG8_WAIT_L(0); PG8_BAR; PG8_MMA(1, 0, At, B0); PG8_MMA(1, 1, At, B1); PG8_BAR; PG8_SCHED;
            PG8_LDB(B0, 1, 0); PG8_LDB(B1, 1, 1); PG8_SCHED; PG8_LDA(At, 1, 0); PG8_STAGE(PG8_SA(0, 1), a2 + hstep, voffA);
            PG8_WAIT_V(8); PG8_WAIT_L(0); PG8_BAR; PG8_MMA(0, 0, At, B0); PG8_MMA(0, 1, At, B1); PG8_BAR; PG8_SCHED;
            PG8_LDA(At, 1, 1); PG8_STAGE(PG8_SB(1, 0), b3, voffB); PG8_STAGE(PG8_SB(1, 1), b3 + hstep, voffB); PG8_STAGE(PG8_SA(1, 0), a3, voffA);
            PG8_WAIT_V(8); PG8_WAIT_L(0); PG8_BAR; PG8_MMA(1, 0, At, B0); PG8_MMA(1, 1, At, B1); PG8_BAR; PG8_SCHED;
            } else {
            PG8_LDB(B0, 0, 0); PG8_SCHED; PG8_LDA(At, 0, 0); PG8_STAGE(PG8_SA(1, 1), a1 + hstep, voffA);
            PG8_WAIT_L(8); PG8_BAR; PG8_WAIT_L(0); PG8_MMA(0, 0, At, B0); PG8_BAR; PG8_SCHED;
            PG8_LDB(B1, 0, 1); PG8_STAGE(PG8_SB(0, 0), b2, voffB);
            PG8_BAR; PG8_WAIT_L(0); PG8_MMA(0, 1, At, B1); PG8_BAR;
            PG8_LDA(At, 0, 1); PG8_STAGE(PG8_SA(0, 0), a2, voffA);
            PG8_BAR; PG8_WAIT_L(0); PG8_MMA(1, 0, At, B0); PG8_BAR; PG8_SCHED;
            PG8_STAGE(PG8_SB(0, 1), b2 + hstep, voffB);
            PG8_WAIT_V(6); PG8_BAR; PG8_MMA(1, 1, At, B1); PG8_BAR;
            PG8_LDB(B0, 1, 0); PG8_SCHED; PG8_LDA(At, 1, 0); PG8_STAGE(PG8_SA(0, 1), a2 + hstep, voffA);
            PG8_WAIT_L(8); PG8_BAR; PG8_WAIT_L(0); PG8_MMA(0, 0, At, B0); PG8_BAR; PG8_SCHED;
            PG8_LDB(B1, 1, 1); PG8_STAGE(PG8_SB(1, 0), b3, voffB);
            PG8_BAR; PG8_WAIT_L(0); PG8_MMA(0, 1, At, B1); PG8_BAR;
            PG8_LDA(At, 1, 1); PG8_STAGE(PG8_SA(1, 0), a3, voffA);
            PG8_BAR; PG8_WAIT_L(0); PG8_MMA(1, 0, At, B0); PG8_BAR; PG8_SCHED;
            PG8_STAGE(PG8_SB(1, 1), b3 + hstep, voffB);
            PG8_WAIT_V(6); PG8_BAR; PG8_MMA(1, 1, At, B1); PG8_BAR;
            }
        }
        if constexpr (ALIGN_EPI) { if (wr == 0) PG8_BAR; }
        E(acc, cur, wr, wc, fr, fq); S.done(cur);
        if (!has_next) break;
#pragma unroll
        for (int a = 0; a < 2; ++a)
#pragma unroll
            for (int b = 0; b < 2; ++b)
#pragma unroll
                for (int m = 0; m < 4; ++m)
#pragma unroll
                    for (int n = 0; n < 2; ++n) acc[a][b][m][n] = (f32x4){0.f, 0.f, 0.f, 0.f};
        cur = nxt; cA = nA; cB = nB; ++ui;
        if constexpr (ALIGN_EPI) { if (wr == 1) PG8_BAR; }
    }
    PG8_WAIT_V(0);
    if constexpr (!ALIGN_EPI) { if (wr == 0) PG8_BAR; }
    PG8_BAR;
#undef PG8_SA
#undef PG8_SB
#undef PG8_STAGE
#undef PG8_LDA
#undef PG8_LDB
#undef PG8_MMA
#undef PG8_WAIT_V
#undef PG8_WAIT_L
#undef PG8_BAR
#undef PG8_SCHED
}
}

enum { M_INPROJ = 0, M_Q = 1, M_KV = 2, M_OUT = 3, M_UP = 4 };
__device__ __forceinline__ void st_bf4(bf16_t* p, f32x4 v) { u32x2 w; w.x = pk2(v[0], v[1]); w.y = pk2(v[2], v[3]); *(u32x2*)p = w; }
__device__ __forceinline__ float dot4(f32x4 v) { return (v[0] * v[0] + v[1] * v[1]) + (v[2] * v[2] + v[3] * v[3]); }
__device__ __forceinline__ float softplusf(float x) { return x > 20.f ? x : log1pf(__expf(x)); }

__device__ __forceinline__ void st_bf8(bf16_t* p, f32x4 a, f32x4 b) { u32x4 w; w.x = pk2(a[0], a[1]); w.y = pk2(a[2], a[3]); w.z = pk2(b[0], b[1]); w.w = pk2(b[2], b[3]); *(u32x4*)p = w; }
__device__ __forceinline__ f32x4 shfl32_4(f32x4 v) { f32x4 r; r[0] = __shfl_xor(v[0], 32); r[1] = __shfl_xor(v[1], 32); r[2] = __shfl_xor(v[2], 32); r[3] = __shfl_xor(v[3], 32); return r; }
__device__ __forceinline__ void rope_perm(f32x4& v0, f32x4& v1, const float* COS, const float* SIN, int row, int fq) {
    const f32x4 p0 = shfl32_4(v0), p1 = shfl32_4(v1);
    const int i0 = 8 * (fq & 1);
    const f32x4 c0 = *(const f32x4*)(COS + (size_t)row * 16 + i0), c1 = *(const f32x4*)(COS + (size_t)row * 16 + i0 + 4);
    const f32x4 s0 = *(const f32x4*)(SIN + (size_t)row * 16 + i0), s1 = *(const f32x4*)(SIN + (size_t)row * 16 + i0 + 4);
    if (fq < 2) { v0 = v0 * c0 - p0 * s0; v1 = v1 * c1 - p1 * s1; }
    else        { v0 = v0 * c0 + p0 * s0; v1 = v1 * c1 + p1 * s1; }
}

template <int MODE> struct Epi {
    static constexpr bool PERM = true, AFTER_DRAIN = false;
    WsPtrs P; const float* dtb; bf16_t* dst;
    __device__ __forceinline__ void operator()(const f32x4 (&acc)[2][2][4][2], const pg8::Unit& u, int wr, int wc, int fr, int fq) const {
        const int pn = u.pn;
        const int rowb = u.pm * 256 + wr * 64 + fr;
#pragma unroll
        for (int ai = 0; ai < 2; ++ai)
#pragma unroll
            for (int m = 0; m < 4; ++m) {
                const int row = rowb + ai * 128 + m * 16;
                if constexpr (MODE == M_INPROJ) {
                    const float rstd = rsqrtf(P.SSQH()[row] * (1.f / 1024.f) + EPS);
                    if (pn < 10) {
                        bf16_t* d; int ld, colt;
                        if (pn < 3) { d = P.CQ(); ld = 768; colt = pn * 256; } else if (pn == 3) { d = P.CKV(); ld = 256; colt = 0; }
                        else if (pn < 6) { d = P.Z(); ld = 512; colt = (pn - 4) * 256; } else { d = P.XBC(); ld = 1024; colt = (pn - 6) * 256; }
                        bf16_t* rp = d + (size_t)row * ld + colt + wc * 32 + 8 * fq;
                        float ss = 0.f;
#pragma unroll
                        for (int bj = 0; bj < 2; ++bj) { const f32x4 v0 = acc[ai][bj][m][0] * rstd, v1 = acc[ai][bj][m][1] * rstd; ss += dot4(v0) + dot4(v1); st_bf8(rp + bj * 128, v0, v1); }
                        if (pn < 4) { ss += __shfl_xor(ss, 16); ss += __shfl_xor(ss, 32);
                            if (fq == 0) { if (pn < 3) P.SSQQ()[(size_t)row * 12 + pn * 4 + wc] = ss; else P.SSQKV()[(size_t)row * 4 + wc] = ss; } }
                    } else {
                        if (wc == 0) {
                            f32x4 v0 = acc[ai][0][m][0] * rstd, v1 = acc[ai][0][m][1] * rstd;
                            rope_perm(v0, v1, P.COS(), P.SIN(), row, fq);
                            st_bf8(P.KR() + (size_t)row * 32 + 8 * fq, v0, v1);
                        } else if (wc == 1) {
                            if (fq == 0) { const f32x4 v0 = acc[ai][0][m][0] * rstd, v1 = acc[ai][0][m][1] * rstd; f32x4 o0, o1;
#pragma unroll
                                for (int j = 0; j < 4; ++j) { o0[j] = softplusf(v0[j] + dtb[j]); o1[j] = softplusf(v1[j] + dtb[4 + j]); }
                                *(f32x4*)(P.DT() + (size_t)row * 8) = o0; *(f32x4*)(P.DT() + (size_t)row * 8 + 4) = o1; }
                        }
                    }
                    asm volatile("" ::: "memory");
                } else if constexpr (MODE == M_Q) {
                    const f32x4 s0 = *(const f32x4*)(P.SSQQ() + (size_t)row * 12), s1 = *(const f32x4*)(P.SSQQ() + (size_t)row * 12 + 4), s2 = *(const f32x4*)(P.SSQQ() + (size_t)row * 12 + 8);
                    const float ssq = ((s0[0] + s0[1]) + (s0[2] + s0[3])) + ((s1[0] + s1[1]) + (s1[2] + s1[3])) + ((s2[0] + s2[1]) + (s2[2] + s2[3]));
                    const float rstd = rsqrtf(ssq * (1.f / 768.f) + EPS) * QSCALE;
#pragma unroll
                    for (int bj = 0; bj < 2; ++bj) {
                        const int gcol = pn * 256 + bj * 128 + wc * 32;
                        f32x4 v0 = acc[ai][bj][m][0] * rstd, v1 = acc[ai][bj][m][1] * rstd;
                        if ((gcol % 96) == 64) rope_perm(v0, v1, P.COS(), P.SIN(), row, fq);
                        st_bf8(P.Q() + (size_t)row * 768 + gcol + 8 * fq, v0, v1);
                    }
                } else if constexpr (MODE == M_KV) {
                    const f32x4 s0 = *(const f32x4*)(P.SSQKV() + (size_t)row * 4);
                    const float rstd = rsqrtf(((s0[0] + s0[1]) + (s0[2] + s0[3])) * (1.f / 256.f) + EPS);
                    if (wc < 2) {
                        char* kb_ = (char*)P.KN() + (size_t)(pn * 128) * 2;
                        const unsigned off = ((unsigned)row * 512u + (unsigned)(wc * 32 + 8 * fq)) * 2u;
#pragma unroll
                        for (int bj = 0; bj < 2; ++bj) st_bf8((bf16_t*)(kb_ + (off + (unsigned)(bj * 64) * 2u)), acc[ai][bj][m][0] * rstd, acc[ai][bj][m][1] * rstd);
                    } else {
                        const int b = (u.pm * 256) >> 13;
                        char* vb_ = (char*)P.VT() + ((size_t)((b * 8 + pn * 2) * 64 + (wc - 2) * 32)) * SEQ * 2;
                        const unsigned off = ((unsigned)(8 * fq) * (unsigned)SEQ + (unsigned)(row & (SEQ - 1))) * 2u;
#pragma unroll
                        for (int bj = 0; bj < 2; ++bj)
#pragma unroll
                            for (int n = 0; n < 2; ++n) { const f32x4 v = acc[ai][bj][m][n] * rstd;
#pragma unroll
                                for (int j = 0; j < 4; ++j)
                                    *(bf16_t*)(vb_ + (off + (unsigned)((bj * 64 + n * 4 + j) * SEQ) * 2u)) = (bf16_t)(pk2(v[j], 0.f) & 0xffffu); }
                    }
                    asm volatile("" ::: "memory");
                } else if constexpr (MODE == M_OUT) {
                    bf16_t* rp = dst + (size_t)row * 1024 + pn * 256 + wc * 32 + 8 * fq;
                    float ss = 0.f;
#pragma unroll
                    for (int bj = 0; bj < 2; ++bj) { const f32x4 v0 = acc[ai][bj][m][0], v1 = acc[ai][bj][m][1]; ss += dot4(v0) + dot4(v1); st_bf8(rp + bj * 128, v0, v1); }
                    ss += __shfl_xor(ss, 16); ss += __shfl_xor(ss, 32);
                    if (fq == 0) P.SSQO()[(size_t)row * 16 + pn * 4 + wc] = ss;
                } else {
                    const float rstd = rsqrtf(P.SSQH()[row] * (1.f / 1024.f) + EPS);
                    bf16_t* rp = P.HID() + (size_t)row * DFF + pn * 256 + wc * 32 + 8 * fq;
#pragma unroll
                    for (int bj = 0; bj < 2; ++bj) {
                        f32x4 v0 = acc[ai][bj][m][0] * rstd, v1 = acc[ai][bj][m][1] * rstd;
#pragma unroll
                        for (int j = 0; j < 4; ++j) { const float r0 = fmaxf(v0[j], 0.f), r1 = fmaxf(v1[j], 0.f); v0[j] = r0 * r0; v1[j] = r1 * r1; }
                        u32x4 w_; w_.x = pk2(v0[0], v0[1]); w_.y = pk2(v0[2], v0[3]); w_.z = pk2(v1[0], v1[1]); w_.w = pk2(v1[2], v1[3]);
                        __builtin_nontemporal_store(w_, (u32x4*)(rp + bj * 128));
                    }
                }
            }
    }
};

__device__ __forceinline__ float wave_sum(float v) {
#pragma unroll
    for (int o = 1; o < 64; o <<= 1) v += __shfl_xor(v, o);
    return v;
}
__device__ __forceinline__ void transpose_item(const float* W, int K, int N, bf16_t* WT, const float* nw, int mapmode, LAS float* scr, int item, int lane) {
    const int nblk = (N + 31) / 32, kb = item / nblk, nb = item % nblk, k0 = 64 * kb, n0 = 32 * nb;
#pragma unroll
    for (int i = 0; i < 8; ++i) { const int kk = 8 * i + (lane >> 3); const int n = n0 + 4 * (lane & 7);
        f32x4 v = (n < N) ? *(const f32x4*)(W + (size_t)(k0 + kk) * N + n) : (f32x4){0.f, 0.f, 0.f, 0.f}; if (nw) v = v * nw[k0 + kk];
        LAS float* d = scr + kk * 33 + 4 * (lane & 7); d[0] = v[0]; d[1] = v[1]; d[2] = v[2]; d[3] = v[3]; }
    asm volatile("s_waitcnt lgkmcnt(0)" ::: "memory");
    const int c = lane & 7;
#pragma unroll
    for (int j = 0; j < 4; ++j) { const int nl = (lane >> 3) + 8 * j; const int n = n0 + nl; const LAS float* s = scr + (8 * c) * 33 + nl;
        if (n < N) {
            int row = n;
            if (mapmode) { if (n >= 1024 && n < 1056) row = 2560 + (n - 1024); else if (n >= 1056 && n < 2592) row = n - 32; }
            u32x4 o; o.x = pk2(s[0 * 33], s[1 * 33]); o.y = pk2(s[2 * 33], s[3 * 33]); o.z = pk2(s[4 * 33], s[5 * 33]); o.w = pk2(s[6 * 33], s[7 * 33]);
            *(u32x4*)(WT + (size_t)row * K + k0 + 8 * c) = o; } }
    asm volatile("s_waitcnt lgkmcnt(0)" ::: "memory");
}

__constant__ float c_invf[16] = {1.0f, 0.5623413324356079f, 0.3162277638912201f, 0.17782793939113617f, 0.10000000149011612f, 0.05623413249850273f, 0.03162277489900589f, 0.017782794311642647f,
    0.009999999776482582f, 0.005623413249850273f, 0.003162277629598975f, 0.0017782794311642647f, 0.0010000000474974513f, 0.000562341301701963f, 0.0003162277571391314f, 0.00017782794020604342f};

struct Params { const float* in[20]; float* out; unsigned char* ws; int ph_lo, ph_hi; };
typedef const __attribute__((address_space(4))) Params* KP;
__device__ __forceinline__ KP kargs() { KP q = (KP)__builtin_amdgcn_kernarg_segment_ptr(); asm volatile("" : "+s"(q)); return q; }

__device__ __forceinline__ void phase_prep(KP pk, const WsPtrs& P, LAS unsigned char* lds, int vcu, int G) {
    const int tid = tid_opaque(), lane = tid & 63, wave = __builtin_amdgcn_readfirstlane(tid >> 6);
    LAS float* scr = (LAS float*)(lds + wave * 8448);
    const int gw = vcu * 8 + wave, NGW = G * 8;
    constexpr int I_IN = 16 * 82, I_UQ = 12 * 24, I_UKV = 4 * 32, I_OUT = 16 * 32, I_UP = 16 * 128, I_DN = 64 * 32, I_L = I_IN + I_UQ + I_UKV + I_OUT + I_UP + I_DN;
    for (int it = gw; it < NLAYER * I_L; it += NGW) {
        const int l = it / I_L; int r = it % I_L;
        unsigned char* wb = pk->ws + (size_t)l * W_LSTRIDE;
        if (r < I_IN) { transpose_item(pk->in[3] + (size_t)l * 1024 * NPROJ_SRC, 1024, NPROJ_SRC, (bf16_t*)(wb + W_IN), pk->in[2] + l * 1024, 1, scr, r, lane); continue; } r -= I_IN;
        if (r < I_UQ) { transpose_item(pk->in[5] + (size_t)l * 768 * 768, 768, 768, (bf16_t*)(wb + W_UQ), pk->in[4] + l * 768, 0, scr, r, lane); continue; } r -= I_UQ;
        if (r < I_UKV) { transpose_item(pk->in[7] + (size_t)l * 256 * 1024, 256, 1024, (bf16_t*)(wb + W_UKV), pk->in[6] + l * 256, 0, scr, r, lane); continue; } r -= I_UKV;
        if (r < I_OUT) { transpose_item(pk->in[14] + (size_t)l * 1024 * 1024, 1024, 1024, (bf16_t*)(wb + W_OUT), nullptr, 0, scr, r, lane); continue; } r -= I_OUT;
        if (r < I_UP) { transpose_item(pk->in[17] + (size_t)l * 1024 * 4096, 1024, 4096, (bf16_t*)(wb + W_UP), pk->in[16] + l * 1024, 0, scr, r, lane); continue; } r -= I_UP;
        transpose_item(pk->in[18] + (size_t)l * 4096 * 1024, 4096, 1024, (bf16_t*)(wb + W_DN), nullptr, 0, scr, r, lane);
    }
    { const int gt = vcu * 512 + tid, NT_ = G * 512; constexpr int NZ16 = 216 * 1024 * 2 / 16;
      for (int i = gt; i < NLAYER * NZ16; i += NT_) { const int l = i / NZ16, r = i % NZ16;
          *(u32x4*)(pk->ws + (size_t)l * W_LSTRIDE + W_IN + (size_t)2600 * 1024 * 2 + (size_t)r * 16) = (u32x4){0u, 0u, 0u, 0u}; } }
    { const int gt = vcu * 512 + tid, NT_ = G * 512; const int* pos = (const int*)pk->in[1];
      for (int i = gt; i < T * 16; i += NT_) { const int t = i >> 4, k = i & 15;
          const float ang = (float)pos[t] * c_invf[k];
          double rev = (double)ang * 0.15915494309189535; rev -= __builtin_rint(rev); const float fr = (float)rev;
          P.COS()[i] = __builtin_amdgcn_cosf(fr); P.SIN()[i] = __builtin_amdgcn_sinf(fr); } }
    for (int row = gw; row < T; row += NGW) {
        const f32x4* xr = (const f32x4*)(pk->in[0] + (size_t)row * DM) + lane; float ss = 0.f;
        u32x2* ob = (u32x2*)(P.HB() + (size_t)row * DM) + lane;
#pragma unroll
        for (int j = 0; j < 4; ++j) { const f32x4 v = __builtin_nontemporal_load(xr + 64 * j); ss += dot4(v); u32x2 w; w.x = pk2(v[0], v[1]); w.y = pk2(v[2], v[3]); ob[64 * j] = w; }
        ss = wave_sum(ss); if (lane == 0) P.SSQH()[row] = ss;
    }
}

template <bool IN_F32, bool OUT_F32>
__device__ __forceinline__ void phase_residual(const float* hin32, float* hout32, const bf16_t* mix, const float* nw, const WsPtrs& P, int vcu, int G) {
    const int tid = tid_opaque(), lane = tid & 63, wave = __builtin_amdgcn_readfirstlane(tid >> 6);
    const int gw = vcu * 8 + wave, NGW = G * 8;
    if constexpr (!IN_F32 && !OUT_F32) {
        f32x4 wa[2], wb[2];
#pragma unroll
        for (int j = 0; j < 2; ++j) { wa[j] = *(const f32x4*)(nw + 8 * lane + 512 * j); wb[j] = *(const f32x4*)(nw + 8 * lane + 512 * j + 4); }
        for (int row0 = gw; row0 < T; row0 += 2 * NGW) {
            float sq[2]; u32x4 hw[2][2], mw[2][2];
#pragma unroll
            for (int k = 0; k < 2; ++k) { const int row = row0 + k * NGW;
                sq[k] = P.SSQO()[(size_t)row * 16 + (lane & 15)];
#pragma unroll
                for (int j = 0; j < 2; ++j) { hw[k][j] = *((const u32x4*)(P.HB() + (size_t)row * DM) + lane + 64 * j); mw[k][j] = __builtin_nontemporal_load((const u32x4*)(mix + (size_t)row * DM) + lane + 64 * j); } }
#pragma unroll
            for (int k = 0; k < 2; ++k) { const int row = row0 + k * NGW;
                float s_ = sq[k]; s_ += __shfl_xor(s_, 1); s_ += __shfl_xor(s_, 2); s_ += __shfl_xor(s_, 4); s_ += __shfl_xor(s_, 8);
                const float rstd = rsqrtf(s_ * (1.f / 1024.f) + EPS);
                float ss = 0.f;
#pragma unroll
                for (int j = 0; j < 2; ++j) {
                    const f32x4 xa = {bflo(hw[k][j].x), bfhi(hw[k][j].x), bflo(hw[k][j].y), bfhi(hw[k][j].y)}, xb = {bflo(hw[k][j].z), bfhi(hw[k][j].z), bflo(hw[k][j].w), bfhi(hw[k][j].w)};
                    const f32x4 ma = {bflo(mw[k][j].x), bfhi(mw[k][j].x), bflo(mw[k][j].y), bfhi(mw[k][j].y)}, mb = {bflo(mw[k][j].z), bfhi(mw[k][j].z), bflo(mw[k][j].w), bfhi(mw[k][j].w)};
                    const f32x4 ha = xa + ma * rstd * wa[j], hb_ = xb + mb * rstd * wb[j];
                    ss += dot4(ha) + dot4(hb_);
                    u32x4 o; o.x = pk2(ha[0], ha[1]); o.y = pk2(ha[2], ha[3]); o.z = pk2(hb_[0], hb_[1]); o.w = pk2(hb_[2], hb_[3]);
                    *((u32x4*)(P.HB() + (size_t)row * DM) + lane + 64 * j) = o;
                }
                ss = wave_sum(ss); if (lane == 0) P.SSQH()[row] = ss; }
        }
        return;
    }
    f32x4 w4[4];
#pragma unroll
    for (int j = 0; j < 4; ++j) w4[j] = *((const f32x4*)nw + lane + 64 * j);
    for (int row0 = gw; row0 < T; row0 += 2 * NGW) {
        float sq[2]; u32x2 hw[2][4], mw[2][4]; f32x4 xf[2][4];
#pragma unroll
        for (int k = 0; k < 2; ++k) { const int row = row0 + k * NGW;
            sq[k] = P.SSQO()[(size_t)row * 16 + (lane & 15)];
#pragma unroll
            for (int j = 0; j < 4; ++j) {
                if (IN_F32) xf[k][j] = __builtin_nontemporal_load((const f32x4*)(hin32 + (size_t)row * DM) + lane + 64 * j);
                else hw[k][j] = ((const u32x2*)(P.HB() + (size_t)row * DM) + lane)[64 * j];
                mw[k][j] = __builtin_nontemporal_load((const u32x2*)(mix + (size_t)row * DM) + lane + 64 * j); } }
#pragma unroll
        for (int k = 0; k < 2; ++k) { const int row = row0 + k * NGW;
            float s_ = sq[k]; s_ += __shfl_xor(s_, 1); s_ += __shfl_xor(s_, 2); s_ += __shfl_xor(s_, 4); s_ += __shfl_xor(s_, 8);
            const float rstd = rsqrtf(s_ * (1.f / 1024.f) + EPS);
            u32x2* hb = (u32x2*)(P.HB() + (size_t)row * DM) + lane;
            float ss = 0.f;
#pragma unroll
            for (int j = 0; j < 4; ++j) {
                f32x4 x;
                if (IN_F32) x = xf[k][j]; else x = (f32x4){bflo(hw[k][j].x), bfhi(hw[k][j].x), bflo(hw[k][j].y), bfhi(hw[k][j].y)};
                const f32x4 mv = {bflo(mw[k][j].x), bfhi(mw[k][j].x), bflo(mw[k][j].y), bfhi(mw[k][j].y)};
                const f32x4 hn = x + mv * rstd * w4[j];
                if (OUT_F32) __builtin_nontemporal_store(hn, (f32x4*)(hout32 + (size_t)row * DM) + lane + 64 * j);
                else { ss += dot4(hn); u32x2 w; w.x = pk2(hn[0], hn[1]); w.y = pk2(hn[2], hn[3]); hb[64 * j] = w; }
            }
            if (!OUT_F32) { ss = wave_sum(ss); if (lane == 0) P.SSQH()[row] = ss; } }
    }
}

constexpr int KPITCH = 208, VPITCH = 144, ATT_KBUF = 64 * KPITCH, ATT_VBUF = 64 * VPITCH, ATT_BUF = ATT_KBUF + ATT_VBUF;
#define MFMA32(a, b, c) __builtin_amdgcn_mfma_f32_32x32x16_bf16(a, b, c, 0, 0, 0)
#define MFMA16(a, b, c) __builtin_amdgcn_mfma_f32_16x16x32_bf16(a, b, c, 0, 0, 0)

__device__ __forceinline__ float max3f(float a, float b, float c) { float r; asm("v_max3_f32 %0, %1, %2, %3" : "=v"(r) : "v"(a), "v"(b), "v"(c)); return r; }
__device__ __forceinline__ float max2f(float a, float b) { float r; asm("v_max_f32_e32 %0, %1, %2" : "=v"(r) : "v"(a), "v"(b)); return r; }
constexpr float ATT_THR = 8.f;
__device__ __forceinline__ void attn_unit(LAS unsigned char* lds, const WsPtrs& P, int b, int h, int qb) {
    const int tid = tid_opaque(), lane = tid & 63, w = __builtin_amdgcn_readfirstlane(tid >> 6), r32 = lane & 31, hi = lane >> 5;
    const int q0 = qb * 256, ntw = 4 * qb + (w >> 1) + 1, NT = 4 * qb + 4;
    const size_t tokb = (size_t)b * SEQ;
    bf16x8 qf[6];
    { const bf16_t* qp = P.Q() + (tokb + q0 + 32 * w + r32) * 768 + h * 96 + 8 * hi;
#pragma unroll
      for (int s = 0; s < 6; ++s) qf[s] = *(const bf16x8*)(qp + 16 * s); }
    const int kr = tid >> 3, kc = tid & 7, rr = (tid >> 2) & 63, rc = tid & 3;
    const char* kbase = (const char*)(P.KN() + tokb * 512 + h * 64);
    const char* rbase = (const char*)(P.KR() + tokb * 32);
    const char* vbase = (const char*)(P.VT() + ((size_t)((b * 8 + h) * 64)) * SEQ);
    const unsigned koff = (unsigned)(kr * 512 + kc * 8) * 2u, roff = (unsigned)(rr * 32 + rc * 8) * 2u, voff = (unsigned)(kr * SEQ + kc * 8) * 2u;
    const int kdst = kr * KPITCH + kc * 16, rdst = rr * KPITCH + 128 + rc * 16, vdst = ATT_KBUF + kr * VPITCH + (kc >> 1) * 32 + (kc & 1) * 8;
    const int kfo = r32 * KPITCH + hi * 16, vfo = ATT_KBUF + r32 * VPITCH + hi * 16;
    u32x4 kregX, rregX = {0u, 0u, 0u, 0u}, vregX, kregY, rregY = {0u, 0u, 0u, 0u}, vregY;
#define ATT_GLOAD(S, t) do { kreg##S = *(const u32x4*)(kbase + (size_t)(t) * (64 * 512 * 2) + koff); rreg##S = *(const u32x4*)(rbase + (size_t)(t) * (64 * 32 * 2) + roff); vreg##S = *(const u32x4*)(vbase + (size_t)(t) * (64 * 2) + voff); } while (0)
#define ATT_LSTORE(S, boff) do { LAS unsigned char* bb = lds + (boff); *(LAS u32x4*)(bb + kdst) = kreg##S; if (w < 4) *(LAS u32x4*)(bb + rdst) = rreg##S;   \
        *(LAS u32x2*)(bb + vdst) = (u32x2){vreg##S.x, vreg##S.y}; *(LAS u32x2*)(bb + vdst + 16) = (u32x2){vreg##S.z, vreg##S.w}; } while (0)
#define ATT_BAR() do { asm volatile("s_waitcnt lgkmcnt(0)" ::: "memory"); __builtin_amdgcn_s_barrier(); asm volatile("" ::: "memory"); } while (0)
#define ATT_QK(P0, P1, boff) do { const LAS unsigned char* kb_ = lds + (boff) + kfo; \
        { const bf16x8 k0 = *(const LAS bf16x8*)(kb_); const bf16x8 k1 = *(const LAS bf16x8*)(kb_ + 32 * KPITCH); P0 = MFMA32(k0, qf[0], negm); P1 = MFMA32(k1, qf[0], negm); } \
        _Pragma("unroll") for (int s_ = 1; s_ < 6; ++s_) { const bf16x8 k0 = *(const LAS bf16x8*)(kb_ + s_ * 32); const bf16x8 k1 = *(const LAS bf16x8*)(kb_ + 32 * KPITCH + s_ * 32); \
            P0 = MFMA32(k0, qf[s_], P0); P1 = MFMA32(k1, qf[s_], P1); } } while (0)
#define ATT_SM1(P0, P1, MREF) do { \
        float rm = max2f(P0[0], P1[0]), rm2_ = max2f(P0[1], P1[1]); \
        _Pragma("unroll") for (int r_ = 2; r_ < 16; r_ += 2) { rm = max3f(rm, P0[r_], P1[r_]); rm2_ = max3f(rm2_, P0[r_ + 1], P1[r_ + 1]); } \
        rm = max2f(rm, rm2_); \
        { auto sw_ = __builtin_amdgcn_permlane32_swap(__float_as_uint(rm), __float_as_uint(rm), false, false); rm = max2f(__uint_as_float(sw_[0]), __uint_as_float(sw_[1])); } \
        const bool need_ = ((MREF) + rm > mrun + ATT_THR) || ((MREF) != mrun); \
        if (__builtin_amdgcn_ballot_w64(need_) != 0ull) { \
            const float mn_ = fmaxf(mrun, (MREF) + rm), alpha_ = __builtin_amdgcn_exp2f(mrun - mn_), sub_ = mn_ - (MREF); \
            lrun *= alpha_; \
            _Pragma("unroll") for (int r_ = 0; r_ < 16; ++r_) { ot0[r_] *= alpha_; ot1[r_] *= alpha_; P0[r_] -= sub_; P1[r_] -= sub_; } \
            mrun = mn_; mcin = mn_; \
            _Pragma("unroll") for (int r_ = 0; r_ < 16; ++r_) negm[r_] = -mn_; \
            asm volatile("" : "+v"(negm)); } } while (0)
#define ATT_SM2(P0, P1) do { \
        f32x2_t sa_ = {0.f, 0.f}, sb_ = {0.f, 0.f}; \
        _Pragma("unroll") for (int r_ = 0; r_ < 16; r_ += 2) { P0[r_] = __builtin_amdgcn_exp2f(P0[r_]); P0[r_ + 1] = __builtin_amdgcn_exp2f(P0[r_ + 1]); P1[r_] = __builtin_amdgcn_exp2f(P1[r_]); P1[r_ + 1] = __builtin_amdgcn_exp2f(P1[r_ + 1]); \
            sa_ += (f32x2_t){P0[r_], P0[r_ + 1]}; sb_ += (f32x2_t){P1[r_], P1[r_ + 1]}; } \
        sa_ += sb_; lrun += sa_.x + sa_.y; } while (0)
#define ATT_PV(P0, P1, boff) do { \
        u32x4 pw_[4]; \
        _Pragma("unroll") for (int j_ = 0; j_ < 4; ++j_) { pw_[0][j_] = pk2(P0[2 * j_], P0[2 * j_ + 1]); pw_[1][j_] = pk2(P0[8 + 2 * j_], P0[9 + 2 * j_]); pw_[2][j_] = pk2(P1[2 * j_], P1[2 * j_ + 1]); pw_[3][j_] = pk2(P1[8 + 2 * j_], P1[9 + 2 * j_]); } \
        const LAS unsigned char* vb_ = lds + (boff) + vfo; \
        _Pragma("unroll") for (int ks_ = 0; ks_ < 4; ++ks_) { \
            const bf16x8 pa_ = __builtin_bit_cast(bf16x8, pw_[ks_]); \
            const bf16x8 vf0 = *(const LAS bf16x8*)(vb_ + ks_ * 32); \
            const bf16x8 vf1 = *(const LAS bf16x8*)(vb_ + 32 * VPITCH + ks_ * 32); \
            ot0 = MFMA32(vf0, pa_, ot0); ot1 = MFMA32(vf1, pa_, ot1); } } while (0)
#define ATT_ROT() do { const int t_ = bc; bc = bn; bn = bnn; bnn = b3; b3 = t_; } while (0)
    if (w < 4) __builtin_amdgcn_s_setprio(1);
    float mrun = -1e30f, lrun = 0.f, mcin = 0.f, mrefA = 0.f, mrefB = 0.f;
    f32x16 ot0 = {}, ot1 = {}, negm = {};
    asm volatile("" : "+v"(negm));
    f32x16 pA0, pA1, pB0, pB1;
    { u32x4 kregZ, rregZ, vregZ;
      ATT_GLOAD(X, 0); ATT_GLOAD(Y, 1); ATT_GLOAD(Z, 2); ATT_LSTORE(X, 0); ATT_LSTORE(Y, ATT_BUF); ATT_LSTORE(Z, 2 * ATT_BUF); }
    ATT_GLOAD(Y, 3); ATT_BAR();
    ATT_QK(pA0, pA1, 0); mrefA = mcin;
    asm volatile("s_nop 15\n\ts_nop 15" : "+v"(pA0), "+v"(pA1));
    if (w >= 4) ATT_BAR();
#define ATT_STEP(PN0, PN1, MREFN, PC0, PC1, MREFC, tt, LS, SS, BC, BN, B3) do {   \
        { const int tl_ = (tt) + 4 < NT ? (tt) + 4 : NT - 1; ATT_GLOAD(LS, tl_); }   \
        if ((tt) < ntw) { ATT_SM1(PC0, PC1, MREFC); __builtin_amdgcn_sched_barrier(0); ATT_QK(PN0, PN1, (BN) * ATT_BUF); MREFN = mcin; ATT_SM2(PC0, PC1); }   \
        ATT_BAR(); \
        if ((tt) < ntw) { ATT_PV(PC0, PC1, (BC) * ATT_BUF); } \
        ATT_LSTORE(SS, (B3) * ATT_BUF); \
        ATT_BAR(); } while (0)
    for (int t = 0; t < NT; t += 4) {
        ATT_STEP(pB0, pB1, mrefB, pA0, pA1, mrefA, t, X, Y, 0, 1, 3);
        ATT_STEP(pA0, pA1, mrefA, pB0, pB1, mrefB, t + 1, Y, X, 1, 2, 0);
        ATT_STEP(pB0, pB1, mrefB, pA0, pA1, mrefA, t + 2, X, Y, 2, 3, 1);
        ATT_STEP(pA0, pA1, mrefA, pB0, pB1, mrefB, t + 3, Y, X, 3, 0, 2);
    }
    if (w < 4) ATT_BAR();
#undef ATT_STEP
    __builtin_amdgcn_s_setprio(0);
    lrun += __shfl_xor(lrun, 32);
    const float inv = 1.f / lrun;
    bf16_t* yp = P.Y() + (tokb + q0 + 32 * w + r32) * 1024 + h * 64 + 4 * hi;
#pragma unroll
    for (int g = 0; g < 4; ++g) {
        st_bf4(yp + 8 * g, (f32x4){ot0[4 * g] * inv, ot0[4 * g + 1] * inv, ot0[4 * g + 2] * inv, ot0[4 * g + 3] * inv});
        st_bf4(yp + 32 + 8 * g, (f32x4){ot1[4 * g] * inv, ot1[4 * g + 1] * inv, ot1[4 * g + 2] * inv, ot1[4 * g + 3] * inv});
    }
#undef ATT_GLOAD
#undef ATT_LSTORE
#undef ATT_QK
#undef ATT_SM1
#undef ATT_SM2
#undef ATT_PV
#undef ATT_ROT
#undef ATT_BAR
}

constexpr int SL_ACS = 0, SL_DTL = 1024, SL_SSQ = 2048, SL_XT = 4096  , XR_PITCH = 544, SL_B = SL_XT + 36864  , BC_PITCH = 272, B1_PITCH = 288  ,
              SL_C = SL_B + 18432  , SL_S = SL_C + 64 * BC_PITCH  , S_PITCH = 144, S_HEAD = 64 * S_PITCH, SL_END = SL_S + 4 * S_HEAD;
static_assert(SL_END <= 131072 && 64 * XR_PITCH <= 36864 && 64 * B1_PITCH <= 18432, "ssd lds");
typedef short v4i16_t __attribute__((ext_vector_type(4)));
__device__ __forceinline__ bf16x8 tr_frag(const LAS unsigned char* img, int pitch, int k0, int colbyte0, int lane) {
    const int g = lane >> 4, q = (lane & 15) >> 2, p = lane & 3;
    const LAS unsigned char* a = img + (k0 + 8 * g + q) * pitch + colbyte0 + p * 8;
    const v4i16_t lo = __builtin_amdgcn_ds_read_tr16_b64_v4i16((LAS v4i16_t*)a), hi = __builtin_amdgcn_ds_read_tr16_b64_v4i16((LAS v4i16_t*)(a + 4 * pitch));
    return (bf16x8){lo[0], lo[1], lo[2], lo[3], hi[0], hi[1], hi[2], hi[3]};
}

__device__ __forceinline__ void ssd_scan_dt(LAS unsigned char* lds, const WsPtrs& P, const float* a_log, size_t t0, int g, int bc, bool write_cdec) {
    const int tid = tid_opaque(), lane = tid & 63, w = __builtin_amdgcn_readfirstlane(tid >> 6);
    if (w < 4) {
        const int head = 4 * g + w;
        const float dtv = P.DT()[(t0 + lane) * 8 + head];
        float a = -dtv * __expf(a_log[head]);
#pragma unroll
        for (int off = 1; off < 64; off <<= 1) { const float t = __shfl_up(a, off); if (lane >= off) a += t; }
        ((LAS float*)(lds + SL_ACS))[w * 64 + lane] = a; ((LAS float*)(lds + SL_DTL))[w * 64 + lane] = dtv;
        if (write_cdec && lane == 63) P.CDEC()[(size_t)bc * 8 + head] = __expf(a);
    }
}

#define SSD_BAR() do { asm volatile("s_waitcnt lgkmcnt(0)" ::: "memory"); __builtin_amdgcn_s_barrier(); asm volatile("" ::: "memory"); } while (0)
struct ConvIn { float wk[4][8]; float bs[8]; u32x4 raw[11]; };
__device__ __forceinline__ void ssd_conv_load(ConvIn& ci, const WsPtrs& P, const float* cw, const float* cb, size_t t0, int c, int g, int tid) {
    const int cg_ = tid & 63, rb = tid >> 6;
    const int col = cg_ < 32 ? g * 256 + cg_ * 8 : (cg_ < 48 ? 512 + g * 128 + (cg_ - 32) * 8 : 768 + g * 128 + (cg_ - 48) * 8);
    const bf16_t* src = P.XBC() + t0 * 1024 + col;
#pragma unroll
    for (int i = 0; i < 11; ++i) { const int lr = 8 * rb - 3 + i;
        if (lr < 0 && c == 0) ci.raw[i] = (u32x4){0u, 0u, 0u, 0u}; else ci.raw[i] = *(const u32x4*)(src + (ptrdiff_t)lr * 1024); }
#pragma unroll
    for (int k = 0; k < 4; ++k) { const f32x4 a = *(const f32x4*)(cw + k * 1024 + col), b2 = *(const f32x4*)(cw + k * 1024 + col + 4);
#pragma unroll
        for (int e = 0; e < 4; ++e) { ci.wk[k][e] = a[e]; ci.wk[k][4 + e] = b2[e]; } }
    { const f32x4 a = *(const f32x4*)(cb + col), b2 = *(const f32x4*)(cb + col + 4);
#pragma unroll
      for (int e = 0; e < 4; ++e) { ci.bs[e] = a[e]; ci.bs[4 + e] = b2[e]; } }
}
template <int MODE>
__device__ __forceinline__ void ssd_conv_compute(const ConvIn& ci, LAS unsigned char* lds, int tid) {
    const int cg_ = tid & 63, rb = tid >> 6;
    if (MODE == 1 && cg_ >= 48) return;
    const LAS float* ACS = (const LAS float*)(lds + SL_ACS); const LAS float* DTL = (const LAS float*)(lds + SL_DTL);
    const int hh = cg_ >> 3;
    LAS unsigned char* base; int pitch;
    if (cg_ < 32) { base = lds + SL_XT + cg_ * 16; pitch = XR_PITCH; }
    else if (cg_ < 48) { base = lds + SL_B + (cg_ - 32) * 16; pitch = (MODE == 1) ? B1_PITCH : BC_PITCH; }
    else { base = lds + SL_C + (cg_ - 48) * 16; pitch = BC_PITCH; }
#pragma unroll
    for (int r = 0; r < 8; ++r) {
        const int s0 = 8 * rb + r;
        float o[8];
#pragma unroll
        for (int e2 = 0; e2 < 4; ++e2) {
            f32x2_t a2 = {ci.bs[2 * e2], ci.bs[2 * e2 + 1]};
#pragma unroll
            for (int k = 0; k < 4; ++k) { const unsigned wd = ci.raw[r + k][e2]; const f32x2_t x2 = {bflo(wd), bfhi(wd)}; const f32x2_t w2 = {ci.wk[k][2 * e2], ci.wk[k][2 * e2 + 1]}; a2 = x2 * w2 + a2; }
            const f32x2_t n2 = a2 * (-1.4426950408889634f);
            f32x2_t d2; d2.x = __builtin_amdgcn_exp2f(n2.x); d2.y = __builtin_amdgcn_exp2f(n2.y); d2 = d2 + 1.0f;
            f32x2_t r2; r2.x = __builtin_amdgcn_rcpf(d2.x); r2.y = __builtin_amdgcn_rcpf(d2.y);
            const f32x2_t o2 = a2 * r2; o[2 * e2] = o2.x; o[2 * e2 + 1] = o2.y;
        }
        float wgt = 1.f;
        if (MODE == 1 && cg_ < 32) wgt = DTL[hh * 64 + s0] * __expf(ACS[hh * 64 + 63] - ACS[hh * 64 + s0]);
        *(LAS u32x4*)(base + s0 * pitch) = (u32x4){pk2(o[0] * wgt, o[1] * wgt), pk2(o[2] * wgt, o[3] * wgt), pk2(o[4] * wgt, o[5] * wgt), pk2(o[6] * wgt, o[7] * wgt)};
    }
}

__device__ __forceinline__ void ssd_s1_unit(LAS unsigned char* lds, const WsPtrs& P, const float* cw, const float* cb, const float* a_log, int u) {
    const int g = u & 1, c = (u >> 1) & 127, b = u >> 8;
    const int tid = tid_opaque(), lane = tid & 63, w = __builtin_amdgcn_readfirstlane(tid >> 6), r = lane & 15, q4 = lane >> 4;
    const size_t t0 = (size_t)b * SEQ + c * 64;
    ConvIn ci; ssd_conv_load(ci, P, cw, cb, t0, c, g, tid);
    ssd_scan_dt(lds, P, a_log, t0, g, b * NCHUNK + c, true);
    __syncthreads();
    ssd_conv_compute<1>(ci, lds, tid);
    __syncthreads();
    const int hh = w >> 1;
    bf16_t* sb = P.STATES() + ((size_t)((b * NCHUNK + c) * 8 + 4 * g + hh)) * 64 * 128;
#pragma unroll
    for (int pt2 = 0; pt2 < 2; ++pt2) {
        const int pt = 2 * (w & 1) + pt2;
        bf16x8 xb[2];
#pragma unroll
        for (int ks = 0; ks < 2; ++ks) xb[ks] = tr_frag(lds + SL_XT, XR_PITCH, 32 * ks, (hh * 64 + 16 * pt) * 2, lane);
#pragma unroll
        for (int nt = 0; nt < 8; ++nt) {
            f32x4 acc = {0.f, 0.f, 0.f, 0.f};
#pragma unroll
            for (int ks = 0; ks < 2; ++ks) { const bf16x8 bt = tr_frag(lds + SL_B, B1_PITCH, 32 * ks, (16 * nt) * 2, lane); acc = MFMA16(bt, xb[ks], acc); }
            st_bf4(sb + (size_t)(16 * pt + r) * 128 + 16 * nt + 4 * q4, acc);
        }
    }
    SSD_BAR();
}

__device__ __forceinline__ void ssd_s2(const WsPtrs& P, int vcu, int G) {
    const int tid = tid_opaque();
    if (tid >= 256) return;
    for (int e = vcu * 256 + tid; e < BATCH * 8 * 64 * 16; e += G * 256) {
        const int n8 = e & 15, pp = (e >> 4) & 63, h = (e >> 10) & 7, b = e >> 13;
        bf16_t* base = P.STATES() + ((size_t)(b * NCHUNK) * 8 + h) * 8192 + pp * 128 + n8 * 8;
        const float* dec = P.CDEC() + (size_t)(b * NCHUNK) * 8 + h;
        float hs[8];
#pragma unroll
        for (int k = 0; k < 8; ++k) hs[k] = 0.f;
        for (int c0 = 0; c0 < NCHUNK; c0 += 8) {
            u32x4 st[8]; float d[8];
#pragma unroll
            for (int i = 0; i < 8; ++i) { st[i] = *(const u32x4*)(base + (size_t)(c0 + i) * 65536); d[i] = dec[(c0 + i) * 8]; }
            asm volatile("" ::: "memory");
#pragma unroll
            for (int i = 0; i < 8; ++i) {
                u32x4 o; o.x = pk2(hs[0], hs[1]); o.y = pk2(hs[2], hs[3]); o.z = pk2(hs[4], hs[5]); o.w = pk2(hs[6], hs[7]);
                *(u32x4*)(base + (size_t)(c0 + i) * 65536) = o;
                hs[0] = hs[0] * d[i] + bflo(st[i].x); hs[1] = hs[1] * d[i] + bfhi(st[i].x); hs[2] = hs[2] * d[i] + bflo(st[i].y); hs[3] = hs[3] * d[i] + bfhi(st[i].y);
                hs[4] = hs[4] * d[i] + bflo(st[i].z); hs[5] = hs[5] * d[i] + bfhi(st[i].z); hs[6] = hs[6] * d[i] + bflo(st[i].w); hs[7] = hs[7] * d[i] + bfhi(st[i].w);
            }
            asm volatile("" ::: "memory");
        }
    }
}

__device__ __forceinline__ void ssd_s3_unit(LAS unsigned char* lds, const WsPtrs& P, const float* cw, const float* cb, const float* a_log, const float* dskip, const float* nrm, int u) {
    const int g = u & 1, c = (u >> 1) & 127, b = u >> 8;
    const int tid = tid_opaque(), lane = tid & 63, w = __builtin_amdgcn_readfirstlane(tid >> 6), r = lane & 15, q4 = lane >> 4;
    const size_t t0 = (size_t)b * SEQ + c * 64;
    ConvIn ci; ssd_conv_load(ci, P, cw, cb, t0, c, g, tid);
    u32x2 zw[2][4];
    { const int hh_ = w >> 1;
#pragma unroll
      for (int a = 0; a < 2; ++a)
#pragma unroll
          for (int pt = 0; pt < 4; ++pt) zw[a][pt] = *(const u32x2*)(P.Z() + (t0 + 16 * (2 * (w & 1) + a) + r) * 512 + (4 * g + hh_) * 64 + 16 * pt + 4 * q4); }
    ssd_scan_dt(lds, P, a_log, t0, g, 0, false);
    __syncthreads();
    ssd_conv_compute<3>(ci, lds, tid);
    bf16x8 pvf[4][4];
    { const bf16_t* pb = P.STATES() + ((size_t)((b * NCHUNK + c) * 8 + 4 * g + (w >> 1))) * 8192;
#pragma unroll
      for (int ks = 0; ks < 4; ++ks)
#pragma unroll
          for (int pt = 0; pt < 4; ++pt) pvf[ks][pt] = *(const bf16x8*)(pb + (size_t)(16 * pt + r) * 128 + ks * 32 + q4 * 8); }
    __syncthreads();
    const LAS float* ACS = (const LAS float*)(lds + SL_ACS); const LAS float* DTL = (const LAS float*)(lds + SL_DTL);
    {
        const int lt = w >> 1;
#pragma unroll
        for (int s2 = 0; s2 < 2; ++s2) {
            const int st = 2 * (w & 1) + s2;
            f32x4 gacc = {0.f, 0.f, 0.f, 0.f};
            if (st <= lt) {
#pragma unroll
                for (int ks = 0; ks < 4; ++ks) {
                    const bf16x8 ca = *(const LAS bf16x8*)(lds + SL_C + (16 * lt + r) * BC_PITCH + ks * 64 + q4 * 16);
                    const bf16x8 bb = *(const LAS bf16x8*)(lds + SL_B + (16 * st + r) * BC_PITCH + ks * 64 + q4 * 16);
                    gacc = MFMA16(bb, ca, gacc);
                }
            }
            const int l = 16 * lt + r, sb = 16 * st + 4 * q4;
#pragma unroll
            for (int hh = 0; hh < 4; ++hh) {
                const float al = ACS[hh * 64 + l];
                const f32x4 as = *(const LAS f32x4*)(ACS + hh * 64 + sb), ds = *(const LAS f32x4*)(DTL + hh * 64 + sb);
                f32x4 v;
#pragma unroll
                for (int i = 0; i < 4; ++i) v[i] = (l >= sb + i) ? gacc[i] * __expf(al - as[i]) * ds[i] : 0.f;
                *(LAS u32x2*)(lds + SL_S + hh * S_HEAD + l * S_PITCH + sb * 2) = (u32x2){pk2(v[0], v[1]), pk2(v[2], v[3])};
            }
        }
    }
    __syncthreads();
    const int hh = w >> 1, head = 4 * g + hh;
    f32x4 acc[2][4];
#pragma unroll
    for (int a = 0; a < 2; ++a)
#pragma unroll
        for (int pt = 0; pt < 4; ++pt) acc[a][pt] = (f32x4){0.f, 0.f, 0.f, 0.f};
    {
#pragma unroll
        for (int ks = 0; ks < 4; ++ks) {
            bf16x8 ca[2];
#pragma unroll
            for (int a = 0; a < 2; ++a) ca[a] = *(const LAS bf16x8*)(lds + SL_C + (16 * (2 * (w & 1) + a) + r) * BC_PITCH + ks * 64 + q4 * 16);
#pragma unroll
            for (int pt = 0; pt < 4; ++pt) {
                const bf16x8 pv = pvf[ks][pt];
#pragma unroll
                for (int a = 0; a < 2; ++a) acc[a][pt] = MFMA16(pv, ca[a], acc[a][pt]);
            }
        }
#pragma unroll
        for (int a = 0; a < 2; ++a) {
            const float sc = __expf(ACS[hh * 64 + 16 * (2 * (w & 1) + a) + r]);
#pragma unroll
            for (int pt = 0; pt < 4; ++pt) acc[a][pt] *= sc;
        }
    }
#pragma unroll
    for (int ks = 0; ks < 2; ++ks) {
        bf16x8 sa[2];
#pragma unroll
        for (int a = 0; a < 2; ++a) sa[a] = *(const LAS bf16x8*)(lds + SL_S + hh * S_HEAD + (16 * (2 * (w & 1) + a) + r) * S_PITCH + ks * 64 + q4 * 16);
#pragma unroll
        for (int pt = 0; pt < 4; ++pt) {
            const bf16x8 xb = tr_frag(lds + SL_XT, XR_PITCH, 32 * ks, (hh * 64 + 16 * pt) * 2, lane);
#pragma unroll
            for (int a = 0; a < 2; ++a) acc[a][pt] = MFMA16(xb, sa[a], acc[a][pt]);
        }
    }
    const float dsk = dskip[head];
#pragma unroll
    for (int a = 0; a < 2; ++a) {
        const int l = 16 * (2 * (w & 1) + a) + r;
        float ssq = 0.f;
#pragma unroll
        for (int pt = 0; pt < 4; ++pt) {
            const int p0 = 16 * pt + 4 * q4;
            const float zv[4] = {bflo(zw[a][pt].x), bfhi(zw[a][pt].x), bflo(zw[a][pt].y), bfhi(zw[a][pt].y)};
            const u32x2 xw = *(const LAS u32x2*)(lds + SL_XT + l * XR_PITCH + (hh * 64 + p0) * 2);
            const float xq[4] = {bflo(xw.x), bfhi(xw.x), bflo(xw.y), bfhi(xw.y)};
#pragma unroll
            for (int i = 0; i < 4; ++i) {
                const float xv = xq[i];
                const float y = (acc[a][pt][i] + dsk * xv) * siluf(zv[i]);
                acc[a][pt][i] = y; ssq += y * y;
            }
        }
        ssq += __shfl_xor(ssq, 16); ssq += __shfl_xor(ssq, 32);
        if (q4 == 0) ((LAS float*)(lds + SL_SSQ))[hh * 64 + l] = ssq;
    }
    __syncthreads();
    {
        const LAS float* SQ = (const LAS float*)(lds + SL_SSQ);
#pragma unroll
        for (int a = 0; a < 2; ++a) {
            const int l = 16 * (2 * (w & 1) + a) + r;
            const float rstd = rsqrtf(((SQ[l] + SQ[64 + l]) + (SQ[128 + l] + SQ[192 + l])) * (1.f / 256.f) + EPS);
#pragma unroll
            for (int pt = 0; pt < 4; ++pt) {
                const int ch = head * 64 + 16 * pt + 4 * q4;
                const f32x4 nw = *(const f32x4*)(nrm + ch);
                st_bf4(P.Y() + (t0 + l) * 1024 + 512 + ch, acc[a][pt] * rstd * nw);
            }
        }
    }
    SSD_BAR();
}

#define XB_TMO      128
#define XB_XCNT(j)  (256  + 64 * (j))
#define XB_XSUB(j)  (1280 + 64 * (j))
#define XB_XGEN(j)  (2304 + 64 * (j))
#define XB_TOP      3328
#define XB_TOPGEN   3392
#define XCD_BAR_WORDS 3456
#define XB_SPIN_CAP (1u << 21)
__device__ __forceinline__ unsigned xb_ld(unsigned* p)              { return __hip_atomic_load(p, __ATOMIC_RELAXED, __HIP_MEMORY_SCOPE_AGENT); }
__device__ __forceinline__ unsigned xb_add(unsigned* p, unsigned v) { return __hip_atomic_fetch_add(p, v, __ATOMIC_RELAXED, __HIP_MEMORY_SCOPE_AGENT); }
__device__ __forceinline__ unsigned xb_xcc_id() { return (unsigned)__builtin_amdgcn_s_getreg((3 << 11) | 20) & 0xFu; }
#define XB_SPIN(cond, bar) do { unsigned _sp = 0; while (cond) { __builtin_amdgcn_s_sleep(0); \
    if ((++_sp & 255u) == 0u) { if (xb_ld(&(bar)[XB_TMO])) break; if (_sp > XB_SPIN_CAP) { atomicAdd(&(bar)[XB_TMO], 1u); break; } } } } while (0)
struct XcdBarrier { unsigned* bar; unsigned x; volatile LAS unsigned* st; };
__device__ __forceinline__ XcdBarrier xcd_barrier_post(unsigned* bar, volatile LAS unsigned* st) {
    XcdBarrier b; b.bar = bar; b.x = xb_xcc_id(); b.st = st;
    if (threadIdx.x == 0) (void)xb_add(&bar[XB_XCNT(b.x)], 1u);
    return b;
}
__device__ __forceinline__ void xcd_barrier_complete(unsigned* bar, unsigned x, unsigned& nloc, unsigned& nx) {
    const unsigned G = gridDim.x * gridDim.y * gridDim.z;
    unsigned sum, cnt, mine, sp = 0u;
    for (;;) {
        sum = 0u; cnt = 0u; mine = 0u;
#pragma unroll
        for (unsigned j = 0; j < 16; ++j) { const unsigned c = xb_ld(&bar[XB_XCNT(j)]); sum += c; cnt += (c > 0u) ? 1u : 0u; mine = (j == x) ? c : mine; }
        if (sum == G) break;
        __builtin_amdgcn_s_sleep(1);
        if ((++sp & 255u) == 0u) { if (xb_ld(&bar[XB_TMO])) break; if (sp > XB_SPIN_CAP) { atomicAdd(&bar[XB_TMO], 1u); break; } }
    }
    nloc = mine > 0u ? mine : 1u; nx = cnt > 0u ? cnt : 1u;
}
__device__ __forceinline__ void xcd_barrier(const XcdBarrier& b) {
    asm volatile("s_waitcnt vmcnt(0)" ::: "memory");
    __syncthreads();
    if (threadIdx.x == 0) {
        unsigned* bar = b.bar;
        __builtin_amdgcn_s_waitcnt(0);
        unsigned nloc = b.st[0], nx = b.st[1];
        if (nloc == 0u) { xcd_barrier_complete(bar, b.x, nloc, nx); b.st[0] = nloc; b.st[1] = nx; }
        const unsigned old = xb_add(&bar[XB_XSUB(b.x)], 1u);
        const unsigned gen = old / nloc;
        if (old + 1u == (gen + 1u) * nloc) {
            __builtin_amdgcn_fence(__ATOMIC_RELEASE, "agent");
            asm volatile("s_waitcnt vmcnt(0)" ::: "memory");
            const unsigned og = xb_add(&bar[XB_TOP], 1u);
            const unsigned tg = og / nx;
            if (og + 1u == (tg + 1u) * nx) xb_add(&bar[XB_TOPGEN], 1u);
            else XB_SPIN(xb_ld(&bar[XB_TOPGEN]) == tg, bar);
            __builtin_amdgcn_fence(__ATOMIC_ACQUIRE, "agent");
            xb_add(&bar[XB_XGEN(b.x)], 1u);
            asm volatile("s_waitcnt vmcnt(0)" ::: "memory");
        } else {
            XB_SPIN(xb_ld(&bar[XB_XGEN(b.x)]) == gen, bar);
            __builtin_amdgcn_fence(__ATOMIC_ACQUIRE, "agent");
            asm volatile("s_waitcnt vmcnt(0)" ::: "memory");
        }
    }
    __syncthreads();
}

constexpr int PH_PER_LAYER = 9, N_PHASES = 1 + NLAYER * PH_PER_LAYER;

#define PH_BEGIN(k) if (ph_lo <= (k) && (k) < ph_hi) { KP pk = kargs(); WsPtrs P; P.ws = pk->ws; int G = gridDim.x, bx = blockIdx.x; asm volatile("" : "+s"(G), "+s"(bx)); \
        const int vcu = (G % 8 == 0) ? (bx % 8) * (G / 8) + bx / 8 : bx; (void)vcu; (void)bx;
#define PH_END(k) if ((k) + 1 < ph_hi) { if ((k) == 0) cg::this_grid().sync(); else xcd_barrier(xb); } }

__device__ __forceinline__ void run_layer(const int l, const int pb, const int ph_lo, const int ph_hi, LAS unsigned char* lds, const XcdBarrier& xb) {
    PH_BEGIN(pb + 0) {
        unsigned char* wb = P.ws + (size_t)l * W_LSTRIDE;
        pg8::Gemm g{P.HB(), (const bf16_t*)(wb + W_IN), T, NPROJ, 1024}; pg8::StaticOrder S; S.init(T, NPROJ, G, bx);
        Epi<M_INPROJ> E{P, pk->in[10] + l * 8, nullptr};
        pg8::gemm_phase<Epi<M_INPROJ>, pg8::StaticOrder, true, true>(lds, g, S, E);
    } PH_END(pb + 0)
    PH_BEGIN(pb + 1) {
        unsigned char* wb = P.ws + (size_t)l * W_LSTRIDE;
        pg8::Gemm g{P.CQ(), (const bf16_t*)(wb + W_UQ), T, 768, 768}; pg8::StaticOrder S; S.init(T, 768, G, bx);
        Epi<M_Q> E{P, nullptr, nullptr}; pg8::gemm_phase<Epi<M_Q>, pg8::StaticOrder, true, true>(lds, g, S, E);
    } }
    PH_BEGIN(pb + 1) {
        unsigned char* wb = P.ws + (size_t)l * W_LSTRIDE;
        pg8::Gemm g{P.CKV(), (const bf16_t*)(wb + W_UKV), T, 1024, 256}; pg8::StaticOrder S; S.init(T, 1024, G, bx);
        Epi<M_KV> E{P, nullptr, nullptr}; pg8::gemm_phase<Epi<M_KV>, pg8::StaticOrder, true, true>(lds, g, S, E);
    } }
    PH_BEGIN(pb + 1) {
        for (int u = vcu; u < BATCH * NCHUNK * 2; u += G) ssd_s1_unit(lds, P, pk->in[8] + l * 4096, pk->in[9] + l * 1024, pk->in[11] + l * 8, u);
    } PH_END(pb + 1)
    PH_BEGIN(pb + 2) {
        ssd_s2(P, vcu, G);
    } }
    PH_BEGIN(pb + 2) {
        for (int u = vcu; u < 2048; u += G) { const int i = u >> 8, vv = u & 255, bh = vv >> 2, s = vv & 3, j = i >> 1;
            const int qb = (i & 1) ? 8 * j + 7 - s : 8 * j + s;
            attn_unit(lds, P, bh >> 3, bh & 7, qb); }
    } PH_END(pb + 2)
    PH_BEGIN(pb + 3) {
        for (int u = vcu; u < BATCH * NCHUNK * 2; u += G) ssd_s3_unit(lds, P, pk->in[8] + l * 4096, pk->in[9] + l * 1024, pk->in[11] + l * 8, pk->in[12] + l * 8, pk->in[13] + l * 512, u);
    } PH_END(pb + 3)
    PH_BEGIN(pb + 4) {
        unsigned char* wb = P.ws + (size_t)l * W_LSTRIDE;
        pg8::Gemm g{P.Y(), (const bf16_t*)(wb + W_OUT), T, 1024, 1024}; pg8::StaticOrder S; S.init(T, 1024, G, bx);
        Epi<M_OUT> E{P, nullptr, P.MIX()}; pg8::gemm_phase<Epi<M_OUT>, pg8::StaticOrder, true, true>(lds, g, S, E);
    } PH_END(pb + 4)
    PH_BEGIN(pb + 5) {
        if (l == 0) phase_residual<true, false>(pk->in[0], nullptr, P.MIX(), pk->in[15] + l * 1024, P, vcu, G);
        else phase_residual<false, false>(nullptr, nullptr, P.MIX(), pk->in[15] + l * 1024, P, vcu, G);
    } PH_END(pb + 5)
    PH_BEGIN(pb + 6) {
        unsigned char* wb = P.ws + (size_t)l * W_LSTRIDE;
        pg8::Gemm g{P.HB(), (const bf16_t*)(wb + W_UP), T, DFF, 1024}; pg8::StaticOrder S; S.init(T, DFF, G, bx);
        Epi<M_UP> E{P, nullptr, nullptr}; pg8::gemm_phase<Epi<M_UP>, pg8::StaticOrder, true, true>(lds, g, S, E);
    } PH_END(pb + 6)
    PH_BEGIN(pb + 7) {
        unsigned char* wb = P.ws + (size_t)l * W_LSTRIDE;
        pg8::Gemm g{P.HID(), (const bf16_t*)(wb + W_DN), T, 1024, DFF}; pg8::StaticOrder S; S.init(T, 1024, G, bx);
        Epi<M_OUT> E{P, nullptr, P.Y()}; pg8::gemm_phase<Epi<M_OUT>, pg8::StaticOrder, true, true>(lds, g, S, E);
    } PH_END(pb + 7)
    PH_BEGIN(pb + 8) {
        if (l == NLAYER - 1) phase_residual<false, true>(nullptr, pk->out, P.Y(), pk->in[19] + l * 1024, P, vcu, G);
        else phase_residual<false, false>(nullptr, nullptr, P.Y(), pk->in[19] + l * 1024, P, vcu, G);
    } PH_END(pb + 8)
}

__global__ void __launch_bounds__(512) fwd_kernel(Params p) {
    extern __shared__ __attribute__((aligned(16))) unsigned char lds_raw[];
    LAS unsigned char* lds = (LAS unsigned char*)lds_raw;
    const int ph_lo = p.ph_lo, ph_hi = p.ph_hi;
    { volatile LAS unsigned* misc = (volatile LAS unsigned*)(lds + LDS_MISC); if (threadIdx.x < 8) misc[threadIdx.x] = 0u; }
    __syncthreads();
    XcdBarrier xb; { KP pk0 = kargs(); xb = xcd_barrier_post((unsigned*)(pk0->ws + WS_BAR), (volatile LAS unsigned*)(lds + LDS_MISC)); }
    PH_BEGIN(0) {
        phase_prep(pk, P, lds, vcu, G);
    } PH_END(0)
    run_layer(0, 1, ph_lo, ph_hi, lds, xb);
    run_layer(1, 1 + PH_PER_LAYER, ph_lo, ph_hi, lds, xb);
}

extern "C" void kernel_launch(void* const* d_in, const int* in_sizes, int n_in, void* d_out, int out_size, void* d_ws, size_t ws_size, hipStream_t stream) {
    static int grid = 0;
    if (grid == 0) {
        if (n_in != 20 || out_size != T * DM || ws_size < WS_NEED) { fprintf(stderr, "kernel_launch: unexpected problem (n_in %d out %d ws %zu)\n", n_in, out_size, ws_size); grid = -1; return; }
        int dev = 0, cus = 0, per_cu = 0;
        hipGetDevice(&dev); hipDeviceGetAttribute(&cus, hipDeviceAttributeMultiprocessorCount, dev);
        if (hipFuncSetAttribute((const void*)fwd_kernel, hipFuncAttributeMaxDynamicSharedMemorySize, LDS_BYTES) != hipSuccess) { fprintf(stderr, "kernel_launch: hipFuncSetAttribute failed\n"); grid = -1; return; }
        if (hipOccupancyMaxActiveBlocksPerMultiprocessor(&per_cu, (const void*)fwd_kernel, 512, LDS_BYTES) != hipSuccess || per_cu < 1) { fprintf(stderr, "kernel_launch: occupancy query says %d\n", per_cu); per_cu = 1; }
        (void)hipGetLastError();
        grid = cus;
    }
    if (grid < 0) return;
    (void)hipMemsetAsync((char*)d_ws + WS_BAR, 0, 16384, stream);
    Params a{};
    for (int i = 0; i < 20; ++i) a.in[i] = (const float*)d_in[i];
    a.out = (float*)d_out; a.ws = (unsigned char*)d_ws;
#if MK_COOP
    a.ph_lo = 0; a.ph_hi = N_PHASES;
    void* args[] = {&a};
    hipError_t e = hipLaunchCooperativeKernel((const void*)fwd_kernel, dim3(grid), dim3(512), args, LDS_BYTES, stream);
    if (e != hipSuccess) fprintf(stderr, "cooperative launch failed: %s (grid %d)\n", hipGetErrorString(e), grid);
#else
    for (int ph = 0; ph < N_PHASES; ++ph) {
        a.ph_lo = ph; a.ph_hi = ph + 1;
        hipLaunchKernelGGL(fwd_kernel, dim3(grid), dim3(512), LDS_BYTES, stream, a);
    }
#endif
}
```
